# Optimizing an MI355X kernel written in HIP

```python
import math
import jax
import jax.numpy as jnp
from jax import lax
import numpy as np

D_MODEL = 1024
BATCH = 8
SEQ = 2048
DEPTH = 2

GRID_W = 64
CTX_LEN = 256
NORM_EPS = 1e-6
ROPE_BASE = 10000.0
RET_HEADS = D_MODEL // 256
RET_DK = 64
RET_DV = 2 * RET_DK
RET_CHUNK = 128
DIFF_HEADS = D_MODEL // 256
DIFF_DH = 64
DIFF_DV = 2 * DIFF_DH
Q_BLOCK = 128
POOL_WINDOWS = (2, 4, 8, 16)
POOL_GROUP = D_MODEL // len(POOL_WINDOWS)
N_EXPERTS = 16
N_EXPERT_GROUPS = 4
EXPERTS_PER_GROUP = N_EXPERTS // N_EXPERT_GROUPS
TOP_K = 2
D_EXPERT = 512
RET_Q_W = RET_HEADS * RET_DK
DIFF_Q_W = DIFF_HEADS * 2 * DIFF_DH
RET_G_W = RET_HEADS * RET_DV
RET_K_W = RET_HEADS * RET_DK
RET_V_W = RET_HEADS * RET_DV
DIFF_K_W = DIFF_HEADS * 2 * DIFF_DH
DIFF_V_W = DIFF_HEADS * DIFF_DV
QG_W = RET_Q_W + DIFF_Q_W + RET_G_W
KV_W = RET_K_W + RET_V_W + DIFF_K_W + DIFF_V_W
IN_W = QG_W + KV_W
QG_SPLITS = (RET_Q_W, RET_Q_W + DIFF_Q_W)
KV_SPLITS = (RET_K_W, RET_K_W + RET_V_W, RET_K_W + RET_V_W + DIFF_K_W)
MIX_W = RET_HEADS * RET_DV + DIFF_HEADS * DIFF_DV
N_EVEN = (DEPTH + 1) // 2
N_ODD = DEPTH // 2

kernel_name = 'hybrid_retention_diffattn_pool_moe_dit'


def rms_norm(x, w):
    xf = x.astype(jnp.float32)
    y = xf * lax.rsqrt(jnp.mean(xf * xf, axis=-1, keepdims=True) + NORM_EPS)
    return (y * w.astype(jnp.float32)).astype(x.dtype)


def head_rms(o):
    of = o.astype(jnp.float32)
    return of * lax.rsqrt(jnp.mean(of * of, axis=-1, keepdims=True) + NORM_EPS)


def modulate(h, shift, scale):
    return h * (1 + scale) + shift


def rope_1d(x, pos):
    half = x.shape[-1] // 2
    inv = ROPE_BASE ** (-jnp.arange(half, dtype=jnp.float32) / half)
    ang = pos.astype(jnp.float32)[:, None] * inv[None, :]
    cos = jnp.cos(ang).astype(x.dtype)
    sin = jnp.sin(ang).astype(x.dtype)
    x1, x2 = x[..., :half], x[..., half:]
    return jnp.concatenate([x1 * cos - x2 * sin, x1 * sin + x2 * cos], axis=-1)


def rope_2d(x, row, col):
    h = x.shape[-1] // 2
    return jnp.concatenate([rope_1d(x[..., :h], row), rope_1d(x[..., h:], col)], axis=-1)


def to_heads(a, n_heads):
    b, t, _ = a.shape
    return a.reshape(b, t, n_heads, -1).transpose(0, 2, 1, 3)


def to_pair_heads(a):
    b, t, _ = a.shape
    return a.reshape(b, t, DIFF_HEADS, 2, DIFF_DH).transpose(0, 2, 3, 1, 4)


def from_heads(o):
    b, h, t, d = o.shape
    return o.transpose(0, 2, 1, 3).reshape(b, t, h * d)


def retention_chunked(q, k, v, log_g, s0):
    b, h, t, dk = q.shape
    dv = v.shape[-1]
    n = t // RET_CHUNK
    qc = q.reshape(b, h, n, RET_CHUNK, dk)
    kc = k.reshape(b, h, n, RET_CHUNK, dk)
    vc = v.reshape(b, h, n, RET_CHUNK, dv)
    pos = jnp.arange(RET_CHUNK, dtype=jnp.float32)
    lg = log_g[:, None]
    gap = pos[:, None] - pos[None, :]
    mask = jnp.where(gap >= 0, jnp.exp(lg[:, :, None] * jnp.maximum(gap, 0.0)[None]), 0.0)
    scores = jnp.einsum('bhnid,bhnjd->bhnij', qc, kc) * mask[None, :, None]
    o_intra = jnp.einsum('bhnij,bhnje->bhnie', scores, vc)
    k_dec = jnp.exp(lg * (RET_CHUNK - 1 - pos))
    q_dec = jnp.exp(lg * (pos + 1))
    c_dec = jnp.exp(log_g * RET_CHUNK)
    kv = jnp.einsum('bhnjd,bhnje->nbhde', kc * k_dec[None, :, None, :, None], vc)

    def step(s, kv_i):
        return c_dec[None, :, None, None] * s + kv_i, s

    s_final, s_in = lax.scan(step, s0, kv)
    o_cross = jnp.einsum('bhnid,nbhde->bhnie', qc * q_dec[None, :, None, :, None], s_in)
    return (o_intra + o_cross).reshape(b, h, t, dv), s_final


def retention_state(k, v, log_g):
    t = k.shape[2]
    dec = jnp.exp(log_g[:, None] * (t - 1 - jnp.arange(t, dtype=jnp.float32)))
    return jnp.einsum('bhtd,bhte->bhde', k * dec[None, :, :, None], v)


def bidir_retention(q, k, v, log_decay, s0_f, s0_b):
    o_f, s_f = retention_chunked(q, k, v, log_decay[0], s0_f)
    o_b, s_b = retention_chunked(jnp.flip(q, 2), jnp.flip(k, 2), jnp.flip(v, 2), log_decay[1], s0_b)
    return o_f + jnp.flip(o_b, 2), s_f, s_b


def diff_softmax_pair(q, k, v, lam):
    s = jnp.einsum('bhcqd,bhckd->bhcqk', q, k).astype(jnp.float32) * (DIFF_DH ** -0.5)
    p = jax.nn.softmax(s, axis=-1)
    a = p[:, :, 0] - lam * p[:, :, 1]
    return jnp.einsum('bhqk,bhkd->bhqd', a.astype(v.dtype), v)


def diff_attention_blocked(q, k_all, v_all, lam):
    b, h, _, t, dh = q.shape
    nb = t // Q_BLOCK
    qb = q.reshape(b, h, 2, nb, Q_BLOCK, dh).transpose(3, 0, 1, 2, 4, 5)
    ob = lax.map(lambda blk: diff_softmax_pair(blk, k_all, v_all, lam), qb)
    return ob.transpose(1, 2, 0, 3, 4).reshape(b, h, t, -1)


def even_mixer(hx, hc, w_in, w_out, log_decay, lam_vec, subln_w, layer_idx, row, col, ctx_out):
    b = hx.shape[0]
    f32 = jnp.float32
    lam_init = 0.8 - 0.6 * math.exp(-0.3 * layer_idx)
    lv = lam_vec.astype(f32)
    lam = jnp.exp(jnp.sum(lv[0] * lv[1])) - jnp.exp(jnp.sum(lv[2] * lv[3])) + lam_init
    ld = log_decay.astype(f32)
    k_scale = RET_DK ** -0.5

    xq, xdq, xg = jnp.split(hx @ w_in[:, :QG_W], QG_SPLITS, axis=-1)
    xk, xv, xdk, xdv = jnp.split(hx @ w_in[:, QG_W:], KV_SPLITS, axis=-1)
    ck, cv, cdk, cdv = jnp.split(hc @ w_in[:, QG_W:], KV_SPLITS, axis=-1)

    rq = rope_2d(to_heads(xq, RET_HEADS), row, col).astype(f32)
    rk = (rope_2d(to_heads(xk, RET_HEADS), row, col) * k_scale).astype(f32)
    rv = to_heads(xv, RET_HEADS).astype(f32)
    crk = (to_heads(ck, RET_HEADS) * k_scale).astype(f32)
    crv = to_heads(cv, RET_HEADS).astype(f32)
    if ctx_out:
        zeros = jnp.zeros((b, RET_HEADS, RET_DK, RET_DV), f32)
        cq, cdq, cg = jnp.split(hc @ w_in[:, :QG_W], QG_SPLITS, axis=-1)
        c_ret, s_f, s_b = bidir_retention(to_heads(cq, RET_HEADS).astype(f32), crk, crv, ld, zeros, zeros)
    else:
        s_f = retention_state(crk, crv, ld[0])
        s_b = retention_state(jnp.flip(crk, 2), jnp.flip(crv, 2), ld[1])
    x_ret, _, _ = bidir_retention(rq, rk, rv, ld, s_f, s_b)

    dq = rope_2d(to_pair_heads(xdq), row, col)
    dk = rope_2d(to_pair_heads(xdk), row, col)
    dv = to_heads(xdv, DIFF_HEADS)
    cdk_h = to_pair_heads(cdk)
    cdv_h = to_heads(cdv, DIFF_HEADS)
    k_all = jnp.concatenate([cdk_h, dk], axis=3)
    v_all = jnp.concatenate([cdv_h, dv], axis=2)
    x_diff = diff_attention_blocked(dq, k_all, v_all, lam)

    def merge(o_ret, gate, o_diff):
        ret = from_heads(head_rms(o_ret)).astype(gate.dtype) * jax.nn.silu(gate)
        dif = from_heads(head_rms(o_diff) * subln_w.astype(f32) * (1.0 - lam_init)).astype(gate.dtype)
        return jnp.concatenate([ret, dif], axis=-1) @ w_out

    out_x = merge(x_ret, xg, x_diff)
    out_c = None
    if ctx_out:
        c_diff = diff_softmax_pair(to_pair_heads(cdq), cdk_h, cdv_h, lam)
        out_c = merge(c_ret, cg, c_diff)
    return out_x, out_c


def pool_mixer(h, pool_w, pool_scale):
    b, t, d = h.shape
    hf = h.astype(jnp.float32)
    cs = jnp.concatenate([jnp.zeros((b, 1, d), jnp.float32), jnp.cumsum(hf, axis=1)], axis=1)
    pos = jnp.arange(t)
    groups = []
    for gi, w in enumerate(POOL_WINDOWS):
        left = w // 2
        right = w - 1 - left
        lo = jnp.clip(pos - left, 0, t)
        hi = jnp.clip(pos + right + 1, 0, t)
        sl = cs[:, :, gi * POOL_GROUP:(gi + 1) * POOL_GROUP]
        mean = (sl[:, hi] - sl[:, lo]) / (hi - lo).astype(jnp.float32)[None, :, None]
        groups.append(mean - hf[:, :, gi * POOL_GROUP:(gi + 1) * POOL_GROUP])
    pooled = jnp.stack(groups, axis=2).astype(h.dtype)
    mixed = jnp.einsum('btgc,gcd->btgd', pooled, pool_w).reshape(b, t, d)
    return mixed * pool_scale


def moe_route(flat, router_w, router_b):
    n = flat.shape[0]
    s = jax.nn.sigmoid((flat @ router_w).astype(jnp.float32))
    biased = s + router_b.astype(jnp.float32)
    grp_score = jnp.sum(lax.top_k(biased.reshape(n, N_EXPERT_GROUPS, EXPERTS_PER_GROUP), TOP_K)[0], axis=-1)
    g_sel = jnp.argmax(grp_score, axis=-1)
    in_group = (jnp.arange(N_EXPERTS) // EXPERTS_PER_GROUP)[None, :] == g_sel[:, None]
    _, idx = lax.top_k(jnp.where(in_group, biased, -jnp.inf), TOP_K)
    w = jnp.take_along_axis(s, idx, axis=-1)
    w = w / jnp.sum(w, axis=-1, keepdims=True)
    return jnp.sum(jax.nn.one_hot(idx, N_EXPERTS, dtype=jnp.float32) * w[..., None], axis=1)


def moe_ffn(h, router_w, router_b, w_gate, w_up, w_down):
    b, t, d = h.shape
    flat = h.reshape(-1, d)
    combine = moe_route(flat, router_w, router_b)
    out = jnp.zeros(flat.shape, jnp.float32)
    for e in range(N_EXPERTS):
        hid = jax.nn.silu(flat @ w_gate[e]) * (flat @ w_up[e])
        out = out + combine[:, e:e + 1] * (hid @ w_down[e]).astype(jnp.float32)
    return out.astype(h.dtype).reshape(b, t, d)


def setup_inputs(seed: int = 0) -> dict:
    key = jax.random.key(seed)
    ks = jax.random.split(key, 21)
    f32 = jnp.float32

    def nrm(k, shape, scale):
        return jax.random.normal(k, shape, f32) * scale

    base_decay = jnp.log1p(-(2.0 ** (-5.0 - jnp.arange(RET_HEADS, dtype=f32))))
    return {
        'x': nrm(ks[0], (BATCH, SEQ, D_MODEL), 1.0),
        'c': nrm(ks[1], (BATCH, D_MODEL), 1.0),
        'ctx': nrm(ks[2], (BATCH, CTX_LEN, D_MODEL), 1.0),
        'c_ctx': nrm(ks[3], (D_MODEL,), 1.0),
        'ada_w': nrm(ks[4], (DEPTH, D_MODEL, 6 * D_MODEL), 0.5 * D_MODEL ** -0.5),
        'ada_b': nrm(ks[5], (DEPTH, 6 * D_MODEL), 0.02),
        'norm_mix_w': 1.0 + nrm(ks[6], (DEPTH, D_MODEL), 0.01),
        'norm_ffn_w': 1.0 + nrm(ks[7], (DEPTH, D_MODEL), 0.01),
        'w_in': nrm(ks[8], (N_EVEN, D_MODEL, IN_W), D_MODEL ** -0.5),
        'w_out': nrm(ks[9], (N_EVEN, MIX_W, D_MODEL), MIX_W ** -0.5),
        'ret_log_decay': base_decay[None, None, :] * (1.0 + nrm(ks[10], (N_EVEN, 2, RET_HEADS), 0.05)),
        'diff_lambda': nrm(ks[11], (N_EVEN, 4, DIFF_DH), 0.1),
        'diff_subln_w': 1.0 + nrm(ks[12], (N_EVEN, DIFF_DV), 0.01),
        'pool_w': nrm(ks[13], (N_ODD, len(POOL_WINDOWS), POOL_GROUP, POOL_GROUP), POOL_GROUP ** -0.5),
        'pool_scale': 1.0 + nrm(ks[14], (N_ODD, D_MODEL), 0.1),
        'router_w': nrm(ks[15], (D_MODEL, N_EXPERTS), D_MODEL ** -0.5),
        'router_b': nrm(ks[16], (N_EXPERTS,), 0.01),
        'moe_w_gate': nrm(ks[17], (DEPTH, N_EXPERTS, D_MODEL, D_EXPERT), D_MODEL ** -0.5),
        'moe_w_up': nrm(ks[18], (DEPTH, N_EXPERTS, D_MODEL, D_EXPERT), D_MODEL ** -0.5),
        'moe_w_down': nrm(ks[19], (DEPTH, N_EXPERTS, D_EXPERT, D_MODEL), D_EXPERT ** -0.5),
        'final_norm_w': 1.0 + nrm(ks[20], (D_MODEL,), 0.01),
    }


def reference(x, c, ctx, c_ctx, ada_w, ada_b, norm_mix_w, norm_ffn_w, w_in, w_out, ret_log_decay,
              diff_lambda, diff_subln_w, pool_w, pool_scale, router_w, router_b, moe_w_gate, moe_w_up,
              moe_w_down, final_norm_w):
    t = x.shape[1]
    rows = t // GRID_W
    row = jnp.repeat(jnp.arange(rows), GRID_W)
    col = jnp.tile(jnp.arange(GRID_W), rows)
    silu_c = jax.nn.silu(c)
    silu_cc = jax.nn.silu(c_ctx)
    cx = ctx
    for l in range(DEPTH):
        even = l % 2 == 0
        li = l // 2
        ctx_after = any(j % 2 == 0 for j in range(l + 1, DEPTH))
        ctx_in = even or ctx_after
        mod = (silu_c @ ada_w[l] + ada_b[l])[:, None, :]
        sh1, sc1, g1, sh2, sc2, g2 = jnp.split(mod, 6, axis=-1)
        hx = modulate(rms_norm(x, norm_mix_w[l]), sh1, sc1)
        hc = None
        if ctx_in:
            cmod = (silu_cc @ ada_w[l] + ada_b[l])[None, None, :]
            csh1, csc1, cg1, csh2, csc2, cg2 = jnp.split(cmod, 6, axis=-1)
            hc = modulate(rms_norm(cx, norm_mix_w[l]), csh1, csc1)
        if even:
            mx, mc = even_mixer(hx, hc, w_in[li], w_out[li], ret_log_decay[li], diff_lambda[li],
                                diff_subln_w[li], l, row, col, ctx_after)
        else:
            mx = pool_mixer(hx, pool_w[li], pool_scale[li])
            mc = pool_mixer(hc, pool_w[li], pool_scale[li]) if ctx_after else None
        x = x + g1 * mx
        x = x + g2 * moe_ffn(modulate(rms_norm(x, norm_ffn_w[l]), sh2, sc2), router_w, router_b,
                             moe_w_gate[l], moe_w_up[l], moe_w_down[l])
        if ctx_after:
            cx = cx + cg1 * mc
            cx = cx + cg2 * moe_ffn(modulate(rms_norm(cx, norm_ffn_w[l]), csh2, csc2), router_w, router_b,
                                    moe_w_gate[l], moe_w_up[l], moe_w_down[l])
    return rms_norm(x, final_norm_w)
```

```cpp
#include <hip/hip_runtime.h>
#include <stdint.h>
#include <cstdio>

typedef unsigned short bf16_t;
typedef short bf16x8 __attribute__((ext_vector_type(8)));
typedef float f32x4 __attribute__((ext_vector_type(4)));
typedef unsigned u32x4 __attribute__((ext_vector_type(4)));
typedef unsigned u32x2 __attribute__((ext_vector_type(2)));

constexpr int DM = 1024, NB = 8, SEQ = 2048, NTOK = NB * SEQ, CTXL = 256, NCTX = NB * CTXL, NROW = NTOK + NCTX;
constexpr int INW = 3072;
constexpr int C_RQ = 0, C_DQ = 256, C_RG = 768, C_RK = 1280, C_RV = 1536, C_DK = 2048, C_DV = 2560;
constexpr int NE = 16, DE = 512;
constexpr float EPS = 1e-6f;
constexpr float LOG2E = 1.4426950408889634f;
constexpr int ECAP = 16384;
constexpr int HROWS = 37120;

constexpr size_t MiB = 1u << 20;
constexpr size_t WS_CTL = 0;
constexpr size_t WS_MOD = 1 * MiB;
constexpr size_t WS_PAR = 2 * MiB;
constexpr size_t WS_ROUTE = 3 * MiB;
constexpr size_t WS_RA = 160 * MiB;
constexpr size_t WS_RB = 200 * MiB;
constexpr size_t WS_HID = WS_RB;
constexpr size_t WS_Y = WS_RB + (size_t)HROWS * DE * 2;
constexpr size_t WS_END = WS_RB + (size_t)NROW * INW * 2;
static_assert(WS_Y + (size_t)HROWS * DM * 2 <= WS_END + 2 * MiB, "HID+Y fit the PROJ region (+slack)");
constexpr size_t WS_NEED = WS_END + 2 * MiB;

constexpr int CW_CNT = 1024;

__device__ __forceinline__ unsigned f2bf(float f) { unsigned u = __float_as_uint(f); return (u + 0x7fffu + ((u >> 16) & 1u)) >> 16; }
__device__ __forceinline__ float bf2f(unsigned b) { return __uint_as_float(b << 16); }
__device__ __forceinline__ unsigned pk2(float lo, float hi) { return f2bf(lo) | (f2bf(hi) << 16); }
__device__ __forceinline__ float wave_sum(float v) {
#pragma unroll
    for (int o = 1; o < 64; o <<= 1) v += __shfl_xor(v, o);
    return v;
}
__device__ __forceinline__ float wave_max(float v) {
#pragma unroll
    for (int o = 1; o < 64; o <<= 1) v = fmaxf(v, __shfl_xor(v, o));
    return v;
}
__device__ __forceinline__ float silu_f(float x) { return x / (1.f + __expf(-x)); }

struct Ptrs {
    const float *x, *c, *ctx, *c_ctx, *ada_w, *ada_b, *norm_mix_w, *norm_ffn_w, *w_in, *w_out, *ret_log_decay, *diff_lambda, *diff_subln_w,
        *pool_w, *pool_scale, *router_w, *router_b, *moe_w_gate, *moe_w_up, *moe_w_down, *final_norm_w;
    float* out; unsigned char* ws;
};

__global__ void __launch_bounds__(256) k_mod(Ptrs P) {
    __shared__ float sc[9][1024];
    __shared__ float red[4][9][64];
    const int tid = threadIdx.x, l = blockIdx.y, n0 = blockIdx.x * 64;
    for (int i = tid; i < 9 * 1024; i += 256) { const int r = i >> 10, k = i & 1023; const float v = r < 8 ? P.c[r * 1024 + k] : P.c_ctx[k]; sc[r][k] = silu_f(v); }
    __syncthreads();
    const int kq = tid >> 6, j = tid & 63;
    float acc[9];
#pragma unroll
    for (int r = 0; r < 9; ++r) acc[r] = 0.f;
    const float* W = P.ada_w + (size_t)l * 1024 * 6144 + n0 + j;
    for (int k = kq * 256; k < kq * 256 + 256; ++k) {
        const float w = W[(size_t)k * 6144];
#pragma unroll
        for (int r = 0; r < 9; ++r) acc[r] += sc[r][k] * w;
    }
#pragma unroll
    for (int r = 0; r < 9; ++r) red[kq][r][j] = acc[r];
    __syncthreads();
    float* MOD = (float*)(P.ws + WS_MOD);
    for (int i = tid; i < 9 * 64; i += 256) { const int r = i >> 6, jj = i & 63;
        MOD[((size_t)l * 9 + r) * 6144 + n0 + jj] = red[0][r][jj] + red[1][r][jj] + red[2][r][jj] + red[3][r][jj] + P.ada_b[l * 6144 + n0 + jj]; }
    if (blockIdx.x == 0 && blockIdx.y == 0) {
        float* par = (float*)(P.ws + WS_PAR);
        for (int i = tid; i < 64 * 16; i += 256) { const int pos = i >> 4, f = i & 15; const float inv = powf(10000.f, -(float)f / 16.f); const float ang = (float)pos * inv;
            par[2 * i] = cosf(ang); par[2 * i + 1] = sinf(ang); }
        if (tid < 64) {
            const float* lv = P.diff_lambda;
            float a = lv[tid] * lv[64 + tid], b = lv[128 + tid] * lv[192 + tid];
            a = wave_sum(a); b = wave_sum(b);
            if (tid == 0) par[4096] = expf(a) - expf(b) + 0.2f;
        }
    }
}

__device__ __forceinline__ void row_load(const float* p, int lane, f32x4 (&v)[4]) {
#pragma unroll
    for (int j = 0; j < 4; ++j) v[j] = *(const f32x4*)(p + 256 * j + 4 * lane);
}
__device__ __forceinline__ float row_rstd(const f32x4 (&v)[4]) {
    float s = 0.f;
#pragma unroll
    for (int j = 0; j < 4; ++j) s += (v[j].x * v[j].x + v[j].y * v[j].y) + (v[j].z * v[j].z + v[j].w * v[j].w);
    return rsqrtf(wave_sum(s) * (1.f / 1024.f) + EPS);
}
__device__ __forceinline__ void row_normmod(f32x4 (&v)[4], float rstd, const float* nw, const float* sh, const float* sc, int lane) {
#pragma unroll
    for (int j = 0; j < 4; ++j) { const int c = 256 * j + 4 * lane; const f32x4 w = *(const f32x4*)(nw + c), s = *(const f32x4*)(sc + c), h = *(const f32x4*)(sh + c);
        v[j] = (v[j] * rstd * w) * (s + 1.f) + h; }
}
__device__ __forceinline__ void row_store_bf16(bf16_t* p, int lane, const f32x4 (&v)[4]) {
#pragma unroll
    for (int j = 0; j < 4; ++j) { u32x2 w; w.x = pk2(v[j].x, v[j].y); w.y = pk2(v[j].z, v[j].w); *(u32x2*)(p + 256 * j + 4 * lane) = w; }
}

__global__ void __launch_bounds__(256) k_norm_in(Ptrs P) {
    const int lane = threadIdx.x & 63, row = blockIdx.x * 4 + (threadIdx.x >> 6);
    if (row >= NROW) return;
    const float* src = row < NTOK ? P.x + (size_t)row * DM : P.ctx + (size_t)(row - NTOK) * DM;
    const int r = row < NTOK ? row / SEQ : 8;
    const float* MOD = (const float*)(P.ws + WS_MOD) + (size_t)(0 * 9 + r) * 6144;
    f32x4 v[4]; row_load(src, lane, v);
    const float rstd = row_rstd(v);
    row_normmod(v, rstd, P.norm_mix_w, MOD + 0, MOD + 1024, lane);
    row_store_bf16((bf16_t*)(P.ws + WS_RA) + (size_t)row * DM, lane, v);
}

enum { EPI_BF16 = 0, EPI_RESID = 1, EPI_F32 = 2, EPI_GATEUP = 3 };
struct GemmP {
    const bf16_t* A;
    const float* W;
    const unsigned* cnt;
    const int* tok_of;
    const float* w_of;
    void* O;
    const float* aux;
    const float* gvec;
    float* Oresid;
    size_t w_estride;
    int lda, ldw, M, N, K, grouped, ldo, ldaux;
};
template <int EPI>
__global__ void __launch_bounds__(256) k_gemm(GemmP g) {
    __shared__ __attribute__((aligned(16))) bf16_t sA[128][40];
    __shared__ __attribute__((aligned(16))) bf16_t sB[128][40];
    const int tid = threadIdx.x, lane = tid & 63, wid = tid >> 6, wr = wid >> 1, wc = wid & 1, fr = lane & 15, fq = lane >> 4;
    const int m0 = blockIdx.y * 128, n0 = blockIdx.x * 128;
    int Mloc = g.M, rowbase = 0; const float* W = g.W; const int* toks = nullptr; const float* wts = nullptr;
    if (g.grouped) {
        const int e = blockIdx.z; int base = 0, ce = 0;
        for (int i = 0; i < NE; ++i) { const int c = (int)g.cnt[i * 64]; if (i == e) { rowbase = base; ce = c; } base += (c + 255) / 256 * 256; }
        Mloc = ce; if (m0 >= Mloc) return;
        W += (size_t)e * g.w_estride;
        if (g.tok_of) toks = g.tok_of + (size_t)e * ECAP;
        if (g.w_of) wts = g.w_of + (size_t)e * ECAP;
    }
    const int ar = tid >> 1, ac = (tid & 1) * 16;
    int arow = m0 + ar; if (arow >= Mloc) arow = Mloc - 1;
    size_t asrc_row;
    if (g.grouped) asrc_row = toks ? (size_t)toks[arow] : (size_t)(rowbase + arow); else asrc_row = (size_t)arow;
    const bf16_t* Ap = g.A + asrc_row * g.lda + ac;
    const int bk = (tid >> 5) * 4, bn = (tid & 31) * 4;
    f32x4 acc[4][4];
#pragma unroll
    for (int i = 0; i < 4; ++i)
#pragma unroll
        for (int j = 0; j < 4; ++j) acc[i][j] = (f32x4){0.f, 0.f, 0.f, 0.f};
    for (int k0 = 0; k0 < g.K; k0 += 32) {
        const u32x4 a0 = *(const u32x4*)(Ap + k0), a1 = *(const u32x4*)(Ap + k0 + 8);
        f32x4 b[4];
#pragma unroll
        for (int i = 0; i < 4; ++i) b[i] = *(const f32x4*)(W + (size_t)(k0 + bk + i) * g.ldw + n0 + bn);
        __syncthreads();
        *(u32x4*)&sA[ar][ac] = a0; *(u32x4*)&sA[ar][ac + 8] = a1;
#pragma unroll
        for (int j = 0; j < 4; ++j) { u32x2 w; w.x = pk2(b[0][j], b[1][j]); w.y = pk2(b[2][j], b[3][j]); *(u32x2*)&sB[bn + j][bk] = w; }
        __syncthreads();
        bf16x8 af[4], bfr[4];
#pragma unroll
        for (int i = 0; i < 4; ++i) af[i] = *(const bf16x8*)&sA[wr * 64 + i * 16 + fr][fq * 8];
#pragma unroll
        for (int j = 0; j < 4; ++j) bfr[j] = *(const bf16x8*)&sB[wc * 64 + j * 16 + fr][fq * 8];
#pragma unroll
        for (int i = 0; i < 4; ++i)
#pragma unroll
            for (int j = 0; j < 4; ++j) acc[i][j] = __builtin_amdgcn_mfma_f32_16x16x32_bf16(af[i], bfr[j], acc[i][j], 0, 0, 0);
    }
#pragma unroll
    for (int i = 0; i < 4; ++i)
#pragma unroll
        for (int r = 0; r < 4; ++r) {
            const int m = m0 + wr * 64 + i * 16 + fq * 4 + r;
            if (m >= Mloc) continue;
            const size_t orow = g.grouped ? (size_t)(rowbase + m) : (size_t)m;
#pragma unroll
            for (int j = 0; j < 4; ++j) {
                const int n = n0 + wc * 64 + j * 16 + fr; const float v = acc[i][j][r];
                if (EPI == EPI_BF16) ((bf16_t*)g.O)[orow * g.ldo + n] = (bf16_t)f2bf(v);
                else if (EPI == EPI_F32) ((float*)g.O)[orow * g.ldo + n] = v;
                else if (EPI == EPI_RESID) { const int b = m / SEQ; g.Oresid[orow * DM + n] = g.aux[orow * g.ldaux + n] + g.gvec[(size_t)b * 6144 + n] * v; }
                else if (EPI == EPI_GATEUP) { const float gt = g.aux[orow * g.ldaux + n]; ((bf16_t*)g.O)[orow * g.ldo + n] = (bf16_t)f2bf(silu_f(gt) * v * wts[m]); }
            }
        }
}

__global__ void __launch_bounds__(256) k_rope(Ptrs P) {
    bf16_t* PROJ = (bf16_t*)(P.ws + WS_RB);
    const float* tab = (const float*)(P.ws + WS_PAR);
    const int row = blockIdx.x;
    const int tid = threadIdx.x;
    if (row >= NTOK) {
        bf16_t* p = PROJ + (size_t)row * INW + C_RK; p[tid] = (bf16_t)f2bf(bf2f(p[tid]) * 0.125f); return;
    }
    const int t = row % SEQ, prow = t >> 6, pcol = t & 63;
    for (int it = tid; it < 768; it += 256) {
        const int hv = it >> 5, pi = it & 31, half = pi >> 4, f = pi & 15;
        int cb; float scale;
        if (hv < 4) { cb = C_RQ + hv * 64; scale = 1.f; }
        else if (hv < 12) { cb = C_DQ + (hv - 4) * 64; scale = 0.125f * LOG2E; }
        else if (hv < 16) { cb = C_RK + (hv - 12) * 64; scale = 0.125f; }
        else { cb = C_DK + (hv - 16) * 64; scale = 1.f; }
        const int pos = half ? pcol : prow;
        const float cs = tab[2 * (pos * 16 + f)], sn = tab[2 * (pos * 16 + f) + 1];
        bf16_t* p = PROJ + (size_t)row * INW + cb + half * 32 + f;
        const float x1 = bf2f(p[0]), x2 = bf2f(p[16]);
        p[0] = (bf16_t)f2bf((x1 * cs - x2 * sn) * scale); p[16] = (bf16_t)f2bf((x1 * sn + x2 * cs) * scale);
    }
}

__global__ void __launch_bounds__(256) k_attn_naive(Ptrs P) {
    __shared__ float pbuf[4][2304];
    const bf16_t* PROJ = (const bf16_t*)(P.ws + WS_RB);
    bf16_t* MIX = (bf16_t*)(P.ws + WS_RA);
    const float lam = ((const float*)(P.ws + WS_PAR))[4096];
    const int lane = threadIdx.x & 63, w = threadIdx.x >> 6, row = blockIdx.x * 4 + w, h = blockIdx.y, b = row / SEQ;
    float* pb = pbuf[w];
    for (int c = 0; c < 2; ++c) {
        float q[64];
        const bf16_t* qp = PROJ + (size_t)row * INW + C_DQ + h * 128 + c * 64;
#pragma unroll
        for (int d = 0; d < 64; d += 8) { const u32x4 u = *(const u32x4*)(qp + d);
            q[d] = bf2f(u.x & 0xffff); q[d + 1] = bf2f(u.x >> 16); q[d + 2] = bf2f(u.y & 0xffff); q[d + 3] = bf2f(u.y >> 16);
            q[d + 4] = bf2f(u.z & 0xffff); q[d + 5] = bf2f(u.z >> 16); q[d + 6] = bf2f(u.w & 0xffff); q[d + 7] = bf2f(u.w >> 16); }
        float s[36]; float mx = -1e30f;
#pragma unroll
        for (int i = 0; i < 36; ++i) {
            const int kk = lane + 64 * i;
            const size_t krow = kk < CTXL ? (size_t)(NTOK + b * CTXL + kk) : (size_t)(b * SEQ + kk - CTXL);
            const bf16_t* kp = PROJ + krow * INW + C_DK + h * 128 + c * 64;
            float a = 0.f;
#pragma unroll
            for (int d = 0; d < 64; d += 8) { const u32x4 u = *(const u32x4*)(kp + d);
                a += q[d] * bf2f(u.x & 0xffff) + q[d + 1] * bf2f(u.x >> 16) + q[d + 2] * bf2f(u.y & 0xffff) + q[d + 3] * bf2f(u.y >> 16)
                   + q[d + 4] * bf2f(u.z & 0xffff) + q[d + 5] * bf2f(u.z >> 16) + q[d + 6] * bf2f(u.w & 0xffff) + q[d + 7] * bf2f(u.w >> 16); }
            s[i] = a; mx = fmaxf(mx, a);
        }
        mx = wave_max(mx);
        float l = 0.f;
#pragma unroll
        for (int i = 0; i < 36; ++i) { s[i] = exp2f(s[i] - mx); l += s[i]; }
        l = wave_sum(l);
        const float f = (c == 0 ? 1.f : -lam) / l;
#pragma unroll
        for (int i = 0; i < 36; ++i) { const int kk = lane + 64 * i; if (c == 0) pb[kk] = s[i] * f; else pb[kk] += s[i] * f; }
    }
    __builtin_amdgcn_s_waitcnt(0);
    float o0 = 0.f, o1 = 0.f;
    for (int kk = 0; kk < 2304; ++kk) {
        const size_t krow = kk < CTXL ? (size_t)(NTOK + b * CTXL + kk) : (size_t)(b * SEQ + kk - CTXL);
        const bf16_t* vp = PROJ + krow * INW + C_DV + h * 128;
        const float p = pb[kk];
        o0 += p * bf2f(vp[lane]); o1 += p * bf2f(vp[64 + lane]);
    }
    const float ss = wave_sum(o0 * o0 + o1 * o1);
    const float r = rsqrtf(ss * (1.f / 128.f) + EPS) * 0.8f;
    bf16_t* mp = MIX + (size_t)row * DM + 512 + h * 128;
    mp[lane] = (bf16_t)f2bf(o0 * r * P.diff_subln_w[lane]); mp[64 + lane] = (bf16_t)f2bf(o1 * r * P.diff_subln_w[64 + lane]);
}

__global__ void __launch_bounds__(256) k_ret_naive(Ptrs P) {
    __shared__ float pbuf[4][2304];
    const bf16_t* PROJ = (const bf16_t*)(P.ws + WS_RB);
    bf16_t* MIX = (bf16_t*)(P.ws + WS_RA);
    const int lane = threadIdx.x & 63, w = threadIdx.x >> 6, row = blockIdx.x * 4 + w, h = blockIdx.y, b = row / SEQ, n = row % SEQ;
    const float ld0 = P.ret_log_decay[h], ld1 = P.ret_log_decay[4 + h];
    float* pb = pbuf[w];
    float q[64];
    const bf16_t* qp = PROJ + (size_t)row * INW + C_RQ + h * 64;
#pragma unroll
    for (int d = 0; d < 64; d += 8) { const u32x4 u = *(const u32x4*)(qp + d);
        q[d] = bf2f(u.x & 0xffff); q[d + 1] = bf2f(u.x >> 16); q[d + 2] = bf2f(u.y & 0xffff); q[d + 3] = bf2f(u.y >> 16);
        q[d + 4] = bf2f(u.z & 0xffff); q[d + 5] = bf2f(u.z >> 16); q[d + 6] = bf2f(u.w & 0xffff); q[d + 7] = bf2f(u.w >> 16); }
    for (int i = 0; i < 36; ++i) {
        const int kk = lane + 64 * i;
        size_t krow; float wgt;
        if (kk < CTXL) { krow = (size_t)(NTOK + b * CTXL + kk); wgt = __expf(ld0 * (float)(n + 256 - kk)) + __expf(ld1 * (float)(SEQ - n + kk)); }
        else { const int m = kk - CTXL; krow = (size_t)(b * SEQ + m); const int d = n - m; wgt = d > 0 ? __expf(ld0 * (float)d) : (d < 0 ? __expf(ld1 * (float)(-d)) : 2.f); }
        const bf16_t* kp = PROJ + krow * INW + C_RK + h * 64;
        float a = 0.f;
#pragma unroll
        for (int d = 0; d < 64; d += 8) { const u32x4 u = *(const u32x4*)(kp + d);
            a += q[d] * bf2f(u.x & 0xffff) + q[d + 1] * bf2f(u.x >> 16) + q[d + 2] * bf2f(u.y & 0xffff) + q[d + 3] * bf2f(u.y >> 16)
               + q[d + 4] * bf2f(u.z & 0xffff) + q[d + 5] * bf2f(u.z >> 16) + q[d + 6] * bf2f(u.w & 0xffff) + q[d + 7] * bf2f(u.w >> 16); }
        pb[kk] = a * wgt;
    }
    __builtin_amdgcn_s_waitcnt(0);
    float o0 = 0.f, o1 = 0.f;
    for (int kk = 0; kk < 2304; ++kk) {
        const size_t krow = kk < CTXL ? (size_t)(NTOK + b * CTXL + kk) : (size_t)(b * SEQ + kk - CTXL);
        const bf16_t* vp = PROJ + krow * INW + C_RV + h * 128;
        const float p = pb[kk];
        o0 += p * bf2f(vp[lane]); o1 += p * bf2f(vp[64 + lane]);
    }
    const float ss = wave_sum(o0 * o0 + o1 * o1);
    const float r = rsqrtf(ss * (1.f / 128.f) + EPS);
    const bf16_t* gp = PROJ + (size_t)row * INW + C_RG + h * 128;
    bf16_t* mp = MIX + (size_t)row * DM + h * 128;
    mp[lane] = (bf16_t)f2bf(o0 * r * silu_f(bf2f(gp[lane]))); mp[64 + lane] = (bf16_t)f2bf(o1 * r * silu_f(bf2f(gp[64 + lane])));
}

__device__ __forceinline__ void norm2_route(const Ptrs& P, int layer, int row, int lane, f32x4 (&v)[4]) {
    const int b = row / SEQ;
    const float* MOD = (const float*)(P.ws + WS_MOD) + (size_t)(layer * 9 + b) * 6144;
    const float rstd = row_rstd(v);
    row_normmod(v, rstd, P.norm_ffn_w + layer * DM, MOD + 3072, MOD + 4096, lane);
    row_store_bf16((bf16_t*)(P.ws + WS_RA) + (size_t)row * DM, lane, v);
    float lg[16];
#pragma unroll
    for (int e = 0; e < 16; ++e) lg[e] = 0.f;
#pragma unroll
    for (int j = 0; j < 4; ++j)
#pragma unroll
        for (int i = 0; i < 4; ++i) {
            const float hv = v[j][i]; const float* rw = P.router_w + (size_t)(256 * j + 4 * lane + i) * 16;
#pragma unroll
            for (int e4 = 0; e4 < 4; ++e4) { const f32x4 w = *(const f32x4*)(rw + 4 * e4); lg[4 * e4] += hv * w.x; lg[4 * e4 + 1] += hv * w.y; lg[4 * e4 + 2] += hv * w.z; lg[4 * e4 + 3] += hv * w.w; }
        }
#pragma unroll
    for (int e = 0; e < 16; ++e) lg[e] = wave_sum(lg[e]);
    if (lane == 0) {
        float s[16], bz[16];
#pragma unroll
        for (int e = 0; e < 16; ++e) { s[e] = 1.f / (1.f + expf(-lg[e])); bz[e] = s[e] + P.router_b[e]; }
        int gsel = 0; float gbest = -1e30f;
#pragma unroll
        for (int gi = 0; gi < 4; ++gi) {
            float m1 = -1e30f, m2 = -1e30f;
#pragma unroll
            for (int k = 0; k < 4; ++k) { const float t = bz[gi * 4 + k]; if (t > m1) { m2 = m1; m1 = t; } else if (t > m2) m2 = t; }
            const float gs = m1 + m2; if (gs > gbest) { gbest = gs; gsel = gi; }
        }
        int i1 = 0, i2 = 0; float m1 = -1e30f, m2 = -1e30f;
#pragma unroll
        for (int gi = 0; gi < 4; ++gi)
#pragma unroll
            for (int k = 0; k < 4; ++k) if (gi == gsel) { const float t = bz[gi * 4 + k]; const int id = gi * 4 + k;
                if (t > m1) { m2 = m1; i2 = i1; m1 = t; i1 = id; } else if (t > m2) { m2 = t; i2 = id; } }
        float s1 = 0.f, s2 = 0.f;
#pragma unroll
        for (int e = 0; e < 16; ++e) { if (e == i1) s1 = s[e]; if (e == i2) s2 = s[e]; }
        const float inv = 1.f / (s1 + s2);
        unsigned* cnt = (unsigned*)(P.ws + WS_CTL) + CW_CNT + layer * 16 * 64;
        int* tok_e = (int*)(P.ws + WS_ROUTE); int* tok_pos = tok_e + 4 * NTOK;
        int* tok_of = tok_e + 6 * NTOK; float* w_of = (float*)(tok_of + 16 * ECAP);
        const int p1 = (int)atomicAdd(&cnt[i1 * 64], 1u), p2 = (int)atomicAdd(&cnt[i2 * 64], 1u);
        tok_e[2 * row] = i1; tok_e[2 * row + 1] = i2; tok_pos[2 * row] = p1; tok_pos[2 * row + 1] = p2;
        tok_of[i1 * ECAP + p1] = row; tok_of[i2 * ECAP + p2] = row; w_of[i1 * ECAP + p1] = s1 * inv; w_of[i2 * ECAP + p2] = s2 * inv;
    }
}
__global__ void __launch_bounds__(256) k_norm2_route(Ptrs P, int layer) {
    const int lane = threadIdx.x & 63, row = blockIdx.x * 4 + (threadIdx.x >> 6);
    f32x4 v[4]; row_load(P.out + (size_t)row * DM, lane, v);
    norm2_route(P, layer, row, lane, v);
}

__device__ __forceinline__ void moe_combine(const Ptrs& P, int layer, int row, int lane, f32x4 (&v)[4]) {
    const unsigned* cnt = (const unsigned*)(P.ws + WS_CTL) + CW_CNT + layer * 16 * 64;
    const int* tok_e = (const int*)(P.ws + WS_ROUTE); const int* tok_pos = tok_e + 4 * NTOK;
    const int e0 = tok_e[2 * row], e1 = tok_e[2 * row + 1];
    int base = 0, rb0 = 0, rb1 = 0;
    for (int i = 0; i < NE; ++i) { if (i == e0) rb0 = base; if (i == e1) rb1 = base; base += ((int)cnt[i * 64] + 255) / 256 * 256; }
    const bf16_t* Y = (const bf16_t*)(P.ws + WS_Y);
    const bf16_t* y0 = Y + (size_t)(rb0 + tok_pos[2 * row]) * DM; const bf16_t* y1 = Y + (size_t)(rb1 + tok_pos[2 * row + 1]) * DM;
    const float* g2 = (const float*)(P.ws + WS_MOD) + (size_t)(layer * 9 + row / SEQ) * 6144 + 5120;
#pragma unroll
    for (int j = 0; j < 4; ++j) { const int c = 256 * j + 4 * lane; const u32x2 a = *(const u32x2*)(y0 + c), bb = *(const u32x2*)(y1 + c); const f32x4 gg = *(const f32x4*)(g2 + c);
        v[j].x += gg.x * (bf2f(a.x & 0xffff) + bf2f(bb.x & 0xffff)); v[j].y += gg.y * (bf2f(a.x >> 16) + bf2f(bb.x >> 16));
        v[j].z += gg.z * (bf2f(a.y & 0xffff) + bf2f(bb.y & 0xffff)); v[j].w += gg.w * (bf2f(a.y >> 16) + bf2f(bb.y >> 16)); }
}
__global__ void __launch_bounds__(256) k_combine_norm1(Ptrs P) {
    const int lane = threadIdx.x & 63, row = blockIdx.x * 4 + (threadIdx.x >> 6);
    f32x4 v[4]; row_load(P.out + (size_t)row * DM, lane, v);
    moe_combine(P, 0, row, lane, v);
#pragma unroll
    for (int j = 0; j < 4; ++j) *(f32x4*)(P.out + (size_t)row * DM + 256 * j + 4 * lane) = v[j];
    const float* MOD = (const float*)(P.ws + WS_MOD) + (size_t)(1 * 9 + row / SEQ) * 6144;
    const float rstd = row_rstd(v);
    row_normmod(v, rstd, P.norm_mix_w + DM, MOD + 0, MOD + 1024, lane);
    row_store_bf16((bf16_t*)(P.ws + WS_RA) + (size_t)row * DM, lane, v);
}
__global__ void __launch_bounds__(256) k_pool_norm2_route(Ptrs P) {
    const int lane = threadIdx.x & 63, row = blockIdx.x * 4 + (threadIdx.x >> 6);
    const int b = row / SEQ, pos = row % SEQ;
    const bf16_t* Z = (const bf16_t*)(P.ws + WS_Y);
    f32x4 v[4]; row_load(P.out + (size_t)row * DM, lane, v);
    const float* g1 = (const float*)(P.ws + WS_MOD) + (size_t)(1 * 9 + b) * 6144 + 2048;
#pragma unroll
    for (int j = 0; j < 4; ++j) {
        const int w = 2 << j, left = w / 2, right = w - 1 - left;
        int lo = pos - left; if (lo < 0) lo = 0; int hi = pos + right + 1; if (hi > SEQ) hi = SEQ;
        const int c = 256 * j + 4 * lane;
        f32x4 s = {0.f, 0.f, 0.f, 0.f};
        for (int t = lo; t < hi; ++t) { const u32x2 a = *(const u32x2*)(Z + (size_t)(b * SEQ + t) * DM + c);
            s.x += bf2f(a.x & 0xffff); s.y += bf2f(a.x >> 16); s.z += bf2f(a.y & 0xffff); s.w += bf2f(a.y >> 16); }
        const u32x2 a = *(const u32x2*)(Z + (size_t)row * DM + c);
        const f32x4 zc = {bf2f(a.x & 0xffff), bf2f(a.x >> 16), bf2f(a.y & 0xffff), bf2f(a.y >> 16)};
        const float inv = 1.f / (float)(hi - lo);
        const f32x4 ps = *(const f32x4*)(P.pool_scale + c), gg = *(const f32x4*)(g1 + c);
        v[j] += gg * ps * (s * inv - zc);
    }
#pragma unroll
    for (int j = 0; j < 4; ++j) *(f32x4*)(P.out + (size_t)row * DM + 256 * j + 4 * lane) = v[j];
    norm2_route(P, 1, row, lane, v);
}
__global__ void __launch_bounds__(256) k_final(Ptrs P) {
    const int lane = threadIdx.x & 63, row = blockIdx.x * 4 + (threadIdx.x >> 6);
    f32x4 v[4]; row_load(P.out + (size_t)row * DM, lane, v);
    moe_combine(P, 1, row, lane, v);
    const float rstd = row_rstd(v);
#pragma unroll
    for (int j = 0; j < 4; ++j) { const int c = 256 * j + 4 * lane; const f32x4 w = *(const f32x4*)(P.final_norm_w + c); *(f32x4*)(P.out + (size_t)row * DM + c) = v[j] * rstd * w; }
}

extern "C" void kernel_launch(void* const* d_in, const int* in_sizes, int n_in, void* d_out, int out_size, void* d_ws, size_t ws_size, hipStream_t stream) {
    if (n_in != 21 || out_size != NTOK * DM || ws_size < WS_NEED) { fprintf(stderr, "kernel_launch: bad shapes n_in %d out %d ws %zu (need %zu)\n", n_in, out_size, ws_size, (size_t)WS_NEED); return; }
    Ptrs P{};
    const float** pp = (const float**)&P;
    for (int i = 0; i < 21; ++i) pp[i] = (const float*)d_in[i];
    P.out = (float*)d_out; P.ws = (unsigned char*)d_ws;
    unsigned char* ws = P.ws;
    hipMemsetAsync(ws + WS_CTL, 0, 1 * MiB, stream);
    const float* MOD = (const float*)(ws + WS_MOD);
    bf16_t* RA = (bf16_t*)(ws + WS_RA); bf16_t* PROJ = (bf16_t*)(ws + WS_RB);
    int* tok_e = (int*)(ws + WS_ROUTE); int* tok_of = tok_e + 6 * NTOK; float* w_of = (float*)(tok_of + 16 * ECAP);

    k_mod<<<dim3(96, 2), 256, 0, stream>>>(P);
    k_norm_in<<<NROW / 4, 256, 0, stream>>>(P);
    {
        GemmP g{}; g.A = RA; g.lda = DM; g.W = P.w_in; g.ldw = INW; g.M = NTOK; g.N = INW; g.K = DM; g.O = PROJ; g.ldo = INW;
        k_gemm<EPI_BF16><<<dim3(INW / 128, NTOK / 128, 1), 256, 0, stream>>>(g);
        GemmP c = g; c.A = RA + (size_t)NTOK * DM; c.W = P.w_in + 1280; c.M = NCTX; c.N = 1792; c.O = PROJ + (size_t)NTOK * INW + 1280;
        k_gemm<EPI_BF16><<<dim3(1792 / 128, NCTX / 128, 1), 256, 0, stream>>>(c);
    }
    k_rope<<<NROW, 256, 0, stream>>>(P);
    k_attn_naive<<<dim3(NTOK / 4, 4), 256, 0, stream>>>(P);
    k_ret_naive<<<dim3(NTOK / 4, 4), 256, 0, stream>>>(P);
    {
        GemmP g{}; g.A = RA; g.lda = DM; g.W = P.w_out; g.ldw = DM; g.M = NTOK; g.N = DM; g.K = DM; g.aux = P.x; g.ldaux = DM; g.gvec = MOD + 2048; g.Oresid = P.out;
        k_gemm<EPI_RESID><<<dim3(DM / 128, NTOK / 128, 1), 256, 0, stream>>>(g);
    }
    for (int layer = 0; layer < 2; ++layer) {
        if (layer == 0) k_norm2_route<<<NTOK / 4, 256, 0, stream>>>(P, 0);
        const unsigned* cnt = (const unsigned*)(ws + WS_CTL) + CW_CNT + layer * 16 * 64;
        float* GT = (float*)(ws + WS_Y);
        bf16_t* HID = (bf16_t*)(ws + WS_HID); bf16_t* Y = (bf16_t*)(ws + WS_Y);
        GemmP g{}; g.A = RA; g.lda = DM; g.W = P.moe_w_gate + (size_t)layer * NE * DM * DE; g.ldw = DE; g.w_estride = (size_t)DM * DE; g.M = 0; g.N = DE; g.K = DM;
        g.grouped = 1; g.cnt = cnt; g.tok_of = tok_of; g.O = GT; g.ldo = DE;
        k_gemm<EPI_F32><<<dim3(DE / 128, NTOK / 128, NE), 256, 0, stream>>>(g);
        GemmP u = g; u.W = P.moe_w_up + (size_t)layer * NE * DM * DE; u.w_of = w_of; u.O = HID; u.ldo = DE; u.aux = GT; u.ldaux = DE;
        k_gemm<EPI_GATEUP><<<dim3(DE / 128, NTOK / 128, NE), 256, 0, stream>>>(u);
        GemmP d{}; d.A = HID; d.lda = DE; d.W = P.moe_w_down + (size_t)layer * NE * DE * DM; d.ldw = DM; d.w_estride = (size_t)DE * DM; d.N = DM; d.K = DE;
        d.grouped = 1; d.cnt = cnt; d.tok_of = nullptr; d.O = Y; d.ldo = DM;
        k_gemm<EPI_BF16><<<dim3(DM / 128, NTOK / 128, NE), 256, 0, stream>>>(d);
        if (layer == 0) {
            k_combine_norm1<<<NTOK / 4, 256, 0, stream>>>(P);
            for (int gi = 0; gi < 4; ++gi) {
                GemmP z{}; z.A = RA + gi * 256; z.lda = DM; z.W = P.pool_w + (size_t)gi * 256 * 256; z.ldw = 256; z.M = NTOK; z.N = 256; z.K = 256; z.O = Y + gi * 256; z.ldo = DM;
                k_gemm<EPI_BF16><<<dim3(2, NTOK / 128, 1), 256, 0, stream>>>(z);
            }
            k_pool_norm2_route<<<NTOK / 4, 256, 0, stream>>>(P);
        }
    }
    k_final<<<NTOK / 4, 256, 0, stream>>>(P);
}
```

```cpp
#include <hip/hip_runtime.h>
#include <stdint.h>
#include <cstdio>

typedef unsigned short bf16_t;
typedef short bf16x8 __attribute__((ext_vector_type(8)));
typedef float f32x4 __attribute__((ext_vector_type(4)));
typedef unsigned u32x4 __attribute__((ext_vector_type(4)));
typedef unsigned u32x2 __attribute__((ext_vector_type(2)));

constexpr int DM = 1024, NB = 8, SEQ = 2048, NTOK = NB * SEQ, CTXL = 256, NCTX = NB * CTXL, NROW = NTOK + NCTX;
constexpr int INW = 3072;
constexpr int C_RQ = 0, C_DQ = 256, C_RG = 768, C_RK = 1280, C_RV = 1536, C_DK = 2048, C_DV = 2560;
constexpr int NE = 16, DE = 512;
constexpr float EPS = 1e-6f;
constexpr float LOG2E = 1.4426950408889634f;
constexpr int ECAP = 16384;
constexpr int HROWS = 37120;

constexpr size_t MiB = 1u << 20;
constexpr size_t WS_CTL = 0;
constexpr size_t WS_MOD = 1 * MiB;
constexpr size_t WS_PAR = 2 * MiB;
constexpr size_t WS_ROUTE = 3 * MiB;
constexpr size_t WS_RA = 160 * MiB;
constexpr size_t WS_RB = 200 * MiB;
constexpr size_t WS_HID = WS_RB;
constexpr size_t WS_Y = WS_RB + (size_t)HROWS * DE * 2;
constexpr size_t WS_END = WS_RB + (size_t)NROW * INW * 2;
static_assert(WS_Y + (size_t)HROWS * DM * 2 <= WS_END + 2 * MiB, "HID+Y fit the PROJ region (+slack)");
constexpr size_t WS_NEED = WS_END + 2 * MiB;

constexpr int CW_CNT = 1024;

__device__ __forceinline__ unsigned f2bf(float f) { unsigned u = __float_as_uint(f); return (u + 0x7fffu + ((u >> 16) & 1u)) >> 16; }
__device__ __forceinline__ float bf2f(unsigned b) { return __uint_as_float(b << 16); }
__device__ __forceinline__ unsigned pk2(float lo, float hi) { return f2bf(lo) | (f2bf(hi) << 16); }
__device__ __forceinline__ float wave_sum(float v) {
#pragma unroll
    for (int o = 1; o < 64; o <<= 1) v += __shfl_xor(v, o);
    return v;
}
__device__ __forceinline__ float wave_max(float v) {
#pragma unroll
    for (int o = 1; o < 64; o <<= 1) v = fmaxf(v, __shfl_xor(v, o));
    return v;
}
__device__ __forceinline__ float silu_f(float x) { return x / (1.f + __expf(-x)); }

struct Ptrs {
    const float *x, *c, *ctx, *c_ctx, *ada_w, *ada_b, *norm_mix_w, *norm_ffn_w, *w_in, *w_out, *ret_log_decay, *diff_lambda, *diff_subln_w,
        *pool_w, *pool_scale, *router_w, *router_b, *moe_w_gate, *moe_w_up, *moe_w_down, *final_norm_w;
    float* out; unsigned char* ws;
};

__global__ void __launch_bounds__(256) k_mod(Ptrs P) {
    __shared__ float sc[9][1024];
    __shared__ float red[4][9][64];
    const int tid = threadIdx.x, l = blockIdx.y, n0 = blockIdx.x * 64;
    for (int i = tid; i < 9 * 1024; i += 256) { const int r = i >> 10, k = i & 1023; const float v = r < 8 ? P.c[r * 1024 + k] : P.c_ctx[k]; sc[r][k] = silu_f(v); }
    __syncthreads();
    const int kq = tid >> 6, j = tid & 63;
    float acc[9];
#pragma unroll
    for (int r = 0; r < 9; ++r) acc[r] = 0.f;
    const float* W = P.ada_w + (size_t)l * 1024 * 6144 + n0 + j;
    for (int k = kq * 256; k < kq * 256 + 256; ++k) {
        const float w = W[(size_t)k * 6144];
#pragma unroll
        for (int r = 0; r < 9; ++r) acc[r] += sc[r][k] * w;
    }
#pragma unroll
    for (int r = 0; r < 9; ++r) red[kq][r][j] = acc[r];
    __syncthreads();
    float* MOD = (float*)(P.ws + WS_MOD);
    for (int i = tid; i < 9 * 64; i += 256) { const int r = i >> 6, jj = i & 63;
        MOD[((size_t)l * 9 + r) * 6144 + n0 + jj] = red[0][r][jj] + red[1][r][jj] + red[2][r][jj] + red[3][r][jj] + P.ada_b[l * 6144 + n0 + jj]; }
    if (blockIdx.x == 0 && blockIdx.y == 0) {
        float* par = (float*)(P.ws + WS_PAR);
        for (int i = tid; i < 64 * 16; i += 256) { const int pos = i >> 4, f = i & 15; const float inv = powf(10000.f, -(float)f / 16.f); const float ang = (float)pos * inv;
            par[2 * i] = cosf(ang); par[2 * i + 1] = sinf(ang); }
        if (tid < 64) {
            const float* lv = P.diff_lambda;
            float a = lv[tid] * lv[64 + tid], b = lv[128 + tid] * lv[192 + tid];
            a = wave_sum(a); b = wave_sum(b);
            if (tid == 0) par[4096] = expf(a) - expf(b) + 0.2f;
        }
    }
}

__device__ __forceinline__ void row_load(const float* p, int lane, f32x4 (&v)[4]) {
#pragma unroll
    for (int j = 0; j < 4; ++j) v[j] = *(const f32x4*)(p + 256 * j + 4 * lane);
}
__device__ __forceinline__ float row_rstd(const f32x4 (&v)[4]) {
    float s = 0.f;
#pragma unroll
    for (int j = 0; j < 4; ++j) s += (v[j].x * v[j].x + v[j].y * v[j].y) + (v[j].z * v[j].z + v[j].w * v[j].w);
    return rsqrtf(wave_sum(s) * (1.f / 1024.f) + EPS);
}
__device__ __forceinline__ void row_normmod(f32x4 (&v)[4], float rstd, const float* nw, const float* sh, const float* sc, int lane) {
#pragma unroll
    for (int j = 0; j < 4; ++j) { const int c = 256 * j + 4 * lane; const f32x4 w = *(const f32x4*)(nw + c), s = *(const f32x4*)(sc + c), h = *(const f32x4*)(sh + c);
        v[j] = (v[j] * rstd * w) * (s + 1.f) + h; }
}
__device__ __forceinline__ void row_store_bf16(bf16_t* p, int lane, const f32x4 (&v)[4]) {
#pragma unroll
    for (int j = 0; j < 4; ++j) { u32x2 w; w.x = pk2(v[j].x, v[j].y); w.y = pk2(v[j].z, v[j].w); *(u32x2*)(p + 256 * j + 4 * lane) = w; }
}

__global__ void __launch_bounds__(256) k_norm_in(Ptrs P) {
    const int lane = threadIdx.x & 63, row = blockIdx.x * 4 + (threadIdx.x >> 6);
    if (row >= NROW) return;
    const float* src = row < NTOK ? P.x + (size_t)row * DM : P.ctx + (size_t)(row - NTOK) * DM;
    const int r = row < NTOK ? row / SEQ : 8;
    const float* MOD = (const float*)(P.ws + WS_MOD) + (size_t)(0 * 9 + r) * 6144;
    f32x4 v[4]; row_load(src, lane, v);
    const float rstd = row_rstd(v);
    row_normmod(v, rstd, P.norm_mix_w, MOD + 0, MOD + 1024, lane);
    row_store_bf16((bf16_t*)(P.ws + WS_RA) + (size_t)row * DM, lane, v);
}

enum { EPI_BF16 = 0, EPI_RESID = 1, EPI_F32 = 2, EPI_GATEUP = 3 };
struct GemmP {
    const bf16_t* A;
    const float* W;
    const unsigned* cnt;
    const int* tok_of;
    const float* w_of;
    void* O;
    const float* aux;
    const float* gvec;
    float* Oresid;
    size_t w_estride;
    int lda, ldw, M, N, K, grouped, ldo, ldaux;
};
template <int EPI>
__global__ void __launch_bounds__(256) k_gemm(GemmP g) {
    __shared__ __attribute__((aligned(16))) bf16_t sA[128][40];
    __shared__ __attribute__((aligned(16))) bf16_t sB[128][40];
    const int tid = threadIdx.x, lane = tid & 63, wid = tid >> 6, wr = wid >> 1, wc = wid & 1, fr = lane & 15, fq = lane >> 4;
    const int m0 = blockIdx.y * 128, n0 = blockIdx.x * 128;
    int Mloc = g.M, rowbase = 0; const float* W = g.W; const int* toks = nullptr; const float* wts = nullptr;
    if (g.grouped) {
        const int e = blockIdx.z; int base = 0, ce = 0;
        for (int i = 0; i < NE; ++i) { const int c = (int)g.cnt[i * 64]; if (i == e) { rowbase = base; ce = c; } base += (c + 255) / 256 * 256; }
        Mloc = ce; if (m0 >= Mloc) return;
        W += (size_t)e * g.w_estride;
        if (g.tok_of) toks = g.tok_of + (size_t)e * ECAP;
        if (g.w_of) wts = g.w_of + (size_t)e * ECAP;
    }
    const int ar = tid >> 1, ac = (tid & 1) * 16;
    int arow = m0 + ar; if (arow >= Mloc) arow = Mloc - 1;
    size_t asrc_row;
    if (g.grouped) asrc_row = toks ? (size_t)toks[arow] : (size_t)(rowbase + arow); else asrc_row = (size_t)arow;
    const bf16_t* Ap = g.A + asrc_row * g.lda + ac;
    const int bk = (tid >> 5) * 4, bn = (tid & 31) * 4;
    f32x4 acc[4][4];
#pragma unroll
    for (int i = 0; i < 4; ++i)
#pragma unroll
        for (int j = 0; j < 4; ++j) acc[i][j] = (f32x4){0.f, 0.f, 0.f, 0.f};
    for (int k0 = 0; k0 < g.K; k0 += 32) {
        const u32x4 a0 = *(const u32x4*)(Ap + k0), a1 = *(const u32x4*)(Ap + k0 + 8);
        f32x4 b[4];
#pragma unroll
        for (int i = 0; i < 4; ++i) b[i] = *(const f32x4*)(W + (size_t)(k0 + bk + i) * g.ldw + n0 + bn);
        __syncthreads();
        *(u32x4*)&sA[ar][ac] = a0; *(u32x4*)&sA[ar][ac + 8] = a1;
#pragma unroll
        for (int j = 0; j < 4; ++j) { u32x2 w; w.x = pk2(b[0][j], b[1][j]); w.y = pk2(b[2][j], b[3][j]); *(u32x2*)&sB[bn + j][bk] = w; }
        __syncthreads();
        bf16x8 af[4], bfr[4];
#pragma unroll
        for (int i = 0; i < 4; ++i) af[i] = *(const bf16x8*)&sA[wr * 64 + i * 16 + fr][fq * 8];
#pragma unroll
        for (int j = 0; j < 4; ++j) bfr[j] = *(const bf16x8*)&sB[wc * 64 + j * 16 + fr][fq * 8];
#pragma unroll
        for (int i = 0; i < 4; ++i)
#pragma unroll
            for (int j = 0; j < 4; ++j) acc[i][j] = __builtin_amdgcn_mfma_f32_16x16x32_bf16(af[i], bfr[j], acc[i][j], 0, 0, 0);
    }
#pragma unroll
    for (int i = 0; i < 4; ++i)
#pragma unroll
        for (int r = 0; r < 4; ++r) {
            const int m = m0 + wr * 64 + i * 16 + fq * 4 + r;
            if (m >= Mloc) continue;
            const size_t orow = g.grouped ? (size_t)(rowbase + m) : (size_t)m;
#pragma unroll
            for (int j = 0; j < 4; ++j) {
                const int n = n0 + wc * 64 + j * 16 + fr; const float v = acc[i][j][r];
                if (EPI == EPI_BF16) ((bf16_t*)g.O)[orow * g.ldo + n] = (bf16_t)f2bf(v);
                else if (EPI == EPI_F32) ((float*)g.O)[orow * g.ldo + n] = v;
                else if (EPI == EPI_RESID) { const int b = m / SEQ; g.Oresid[orow * DM + n] = g.aux[orow * g.ldaux + n] + g.gvec[(size_t)b * 6144 + n] * v; }
                else if (EPI == EPI_GATEUP) { const float gt = g.aux[orow * g.ldaux + n]; ((bf16_t*)g.O)[orow * g.ldo + n] = (bf16_t)f2bf(silu_f(gt) * v * wts[m]); }
            }
        }
}

__global__ void __launch_bounds__(256) k_rope(Ptrs P) {
    bf16_t* PROJ = (bf16_t*)(P.ws + WS_RB);
    const float* tab = (const float*)(P.ws + WS_PAR);
    const int row = blockIdx.x;
    const int tid = threadIdx.x;
    if (row >= NTOK) {
        bf16_t* p = PROJ + (size_t)row * INW + C_RK; p[tid] = (bf16_t)f2bf(bf2f(p[tid]) * 0.125f); return;
    }
    const int t = row % SEQ, prow = t >> 6, pcol = t & 63;
    for (int it = tid; it < 768; it += 256) {
        const int hv = it >> 5, pi = it & 31, half = pi >> 4, f = pi & 15;
        int cb; float scale;
        if (hv < 4) { cb = C_RQ + hv * 64; scale = 1.f; }
        else if (hv < 12) { cb = C_DQ + (hv - 4) * 64; scale = 0.125f * LOG2E; }
        else if (hv < 16) { cb = C_RK + (hv - 12) * 64; scale = 0.125f; }
        else { cb = C_DK + (hv - 16) * 64; scale = 1.f; }
        const int pos = half ? pcol : prow;
        const float cs = tab[2 * (pos * 16 + f)], sn = tab[2 * (pos * 16 + f) + 1];
        bf16_t* p = PROJ + (size_t)row * INW + cb + half * 32 + f;
        const float x1 = bf2f(p[0]), x2 = bf2f(p[16]);
        p[0] = (bf16_t)f2bf((x1 * cs - x2 * sn) * scale); p[16] = (bf16_t)f2bf((x1 * sn + x2 * cs) * scale);
    }
}

__global__ void __launch_bounds__(256) k_attn_naive(Ptrs P) {
    __shared__ float pbuf[4][2304];
    const bf16_t* PROJ = (const bf16_t*)(P.ws + WS_RB);
    bf16_t* MIX = (bf16_t*)(P.ws + WS_RA);
    const float lam = ((const float*)(P.ws + WS_PAR))[4096];
    const int lane = threadIdx.x & 63, w = threadIdx.x >> 6, row = blockIdx.x * 4 + w, h = blockIdx.y, b = row / SEQ;
    float* pb = pbuf[w];
    for (int c = 0; c < 2; ++c) {
        float q[64];
        const bf16_t* qp = PROJ + (size_t)row * INW + C_DQ + h * 128 + c * 64;
#pragma unroll
        for (int d = 0; d < 64; d += 8) { const u32x4 u = *(const u32x4*)(qp + d);
            q[d] = bf2f(u.x & 0xffff); q[d + 1] = bf2f(u.x >> 16); q[d + 2] = bf2f(u.y & 0xffff); q[d + 3] = bf2f(u.y >> 16);
            q[d + 4] = bf2f(u.z & 0xffff); q[d + 5] = bf2f(u.z >> 16); q[d + 6] = bf2f(u.w & 0xffff); q[d + 7] = bf2f(u.w >> 16); }
        float s[36]; float mx = -1e30f;
#pragma unroll
        for (int i = 0; i < 36; ++i) {
            const int kk = lane + 64 * i;
            const size_t krow = kk < CTXL ? (size_t)(NTOK + b * CTXL + kk) : (size_t)(b * SEQ + kk - CTXL);
            const bf16_t* kp = PROJ + krow * INW + C_DK + h * 128 + c * 64;
            float a = 0.f;
#pragma unroll
            for (int d = 0; d < 64; d += 8) { const u32x4 u = *(const u32x4*)(kp + d);
                a += q[d] * bf2f(u.x & 0xffff) + q[d + 1] * bf2f(u.x >> 16) + q[d + 2] * bf2f(u.y & 0xffff) + q[d + 3] * bf2f(u.y >> 16)
                   + q[d + 4] * bf2f(u.z & 0xffff) + q[d + 5] * bf2f(u.z >> 16) + q[d + 6] * bf2f(u.w & 0xffff) + q[d + 7] * bf2f(u.w >> 16); }
            s[i] = a; mx = fmaxf(mx, a);
        }
        mx = wave_max(mx);
        float l = 0.f;
#pragma unroll
        for (int i = 0; i < 36; ++i) { s[i] = exp2f(s[i] - mx); l += s[i]; }
        l = wave_sum(l);
        const float f = (c == 0 ? 1.f : -lam) / l;
#pragma unroll
        for (int i = 0; i < 36; ++i) { const int kk = lane + 64 * i; if (c == 0) pb[kk] = s[i] * f; else pb[kk] += s[i] * f; }
    }
    __builtin_amdgcn_s_waitcnt(0);
    float o0 = 0.f, o1 = 0.f;
    for (int kk = 0; kk < 2304; ++kk) {
        const size_t krow = kk < CTXL ? (size_t)(NTOK + b * CTXL + kk) : (size_t)(b * SEQ + kk - CTXL);
        const bf16_t* vp = PROJ + krow * INW + C_DV + h * 128;
        const float p = pb[kk];
        o0 += p * bf2f(vp[lane]); o1 += p * bf2f(vp[64 + lane]);
    }
    const float ss = wave_sum(o0 * o0 + o1 * o1);
    const float r = rsqrtf(ss * (1.f / 128.f) + EPS) * 0.8f;
    bf16_t* mp = MIX + (size_t)row * DM + 512 + h * 128;
    mp[lane] = (bf16_t)f2bf(o0 * r * P.diff_subln_w[lane]); mp[64 + lane] = (bf16_t)f2bf(o1 * r * P.diff_subln_w[64 + lane]);
}

__global__ void __launch_bounds__(256) k_ret_naive(Ptrs P) {
    __shared__ float pbuf[4][2304];
    const bf16_t* PROJ = (const bf16_t*)(P.ws + WS_RB);
    bf16_t* MIX = (bf16_t*)(P.ws + WS_RA);
    const int lane = threadIdx.x & 63, w = threadIdx.x >> 6, row = blockIdx.x * 4 + w, h = blockIdx.y, b = row / SEQ, n = row % SEQ;
    const float ld0 = P.ret_log_decay[h], ld1 = P.ret_log_decay[4 + h];
    float* pb = pbuf[w];
    float q[64];
    const bf16_t* qp = PROJ + (size_t)row * INW + C_RQ + h * 64;
#pragma unroll
    for (int d = 0; d < 64; d += 8) { const u32x4 u = *(const u32x4*)(qp + d);
        q[d] = bf2f(u.x & 0xffff); q[d + 1] = bf2f(u.x >> 16); q[d + 2] = bf2f(u.y & 0xffff); q[d + 3] = bf2f(u.y >> 16);
        q[d + 4] = bf2f(u.z & 0xffff); q[d + 5] = bf2f(u.z >> 16); q[d + 6] = bf2f(u.w & 0xffff); q[d + 7] = bf2f(u.w >> 16); }
    for (int i = 0; i < 36; ++i) {
        const int kk = lane + 64 * i;
        size_t krow; float wgt;
        if (kk < CTXL) { krow = (size_t)(NTOK + b * CTXL + kk); wgt = __expf(ld0 * (float)(n + 256 - kk)) + __expf(ld1 * (float)(SEQ - n + kk)); }
        else { const int m = kk - CTXL; krow = (size_t)(b * SEQ + m); const int d = n - m; wgt = d > 0 ? __expf(ld0 * (float)d) : (d < 0 ? __expf(ld1 * (float)(-d)) : 2.f); }
        const bf16_t* kp = PROJ + krow * INW + C_RK + h * 64;
        float a = 0.f;
#pragma unroll
        for (int d = 0; d < 64; d += 8) { const u32x4 u = *(const u32x4*)(kp + d);
            a += q[d] * bf2f(u.x & 0xffff) + q[d + 1] * bf2f(u.x >> 16) + q[d + 2] * bf2f(u.y & 0xffff) + q[d + 3] * bf2f(u.y >> 16)
               + q[d + 4] * bf2f(u.z & 0xffff) + q[d + 5] * bf2f(u.z >> 16) + q[d + 6] * bf2f(u.w & 0xffff) + q[d + 7] * bf2f(u.w >> 16); }
        pb[kk] = a * wgt;
    }
    __builtin_amdgcn_s_waitcnt(0);
    float o0 = 0.f, o1 = 0.f;
    for (int kk = 0; kk < 2304; ++kk) {
        const size_t krow = kk < CTXL ? (size_t)(NTOK + b * CTXL + kk) : (size_t)(b * SEQ + kk - CTXL);
        const bf16_t* vp = PROJ + krow * INW + C_RV + h * 128;
        const float p = pb[kk];
        o0 += p * bf2f(vp[lane]); o1 += p * bf2f(vp[64 + lane]);
    }
    const float ss = wave_sum(o0 * o0 + o1 * o1);
    const float r = rsqrtf(ss * (1.f / 128.f) + EPS);
    const bf16_t* gp = PROJ + (size_t)row * INW + C_RG + h * 128;
    bf16_t* mp = MIX + (size_t)row * DM + h * 128;
    mp[lane] = (bf16_t)f2bf(o0 * r * silu_f(bf2f(gp[lane]))); mp[64 + lane] = (bf16_t)f2bf(o1 * r * silu_f(bf2f(gp[64 + lane])));
}

__device__ __forceinline__ void norm2_route(const Ptrs& P, int layer, int row, int lane, f32x4 (&v)[4]) {
    const int b = row / SEQ;
    const float* MOD = (const float*)(P.ws + WS_MOD) + (size_t)(layer * 9 + b) * 6144;
    const float rstd = row_rstd(v);
    row_normmod(v, rstd, P.norm_ffn_w + layer * DM, MOD + 3072, MOD + 4096, lane);
    row_store_bf16((bf16_t*)(P.ws + WS_RA) + (size_t)row * DM, lane, v);
    float lg[16];
#pragma unroll
    for (int e = 0; e < 16; ++e) lg[e] = 0.f;
#pragma unroll
    for (int j = 0; j < 4; ++j)
#pragma unroll
        for (int i = 0; i < 4; ++i) {
            const float hv = v[j][i]; const float* rw = P.router_w + (size_t)(256 * j + 4 * lane + i) * 16;
#pragma unroll
            for (int e4 = 0; e4 < 4; ++e4) { const f32x4 w = *(const f32x4*)(rw + 4 * e4); lg[4 * e4] += hv * w.x; lg[4 * e4 + 1] += hv * w.y; lg[4 * e4 + 2] += hv * w.z; lg[4 * e4 + 3] += hv * w.w; }
        }
#pragma unroll
    for (int e = 0; e < 16; ++e) lg[e] = wave_sum(lg[e]);
    if (lane == 0) {
        float s[16], bz[16];
#pragma unroll
        for (int e = 0; e < 16; ++e) { s[e] = 1.f / (1.f + expf(-lg[e])); bz[e] = s[e] + P.router_b[e]; }
        int gsel = 0; float gbest = -1e30f;
#pragma unroll
        for (int gi = 0; gi < 4; ++gi) {
            float m1 = -1e30f, m2 = -1e30f;
#pragma unroll
            for (int k = 0; k < 4; ++k) { const float t = bz[gi * 4 + k]; if (t > m1) { m2 = m1; m1 = t; } else if (t > m2) m2 = t; }
            const float gs = m1 + m2; if (gs > gbest) { gbest = gs; gsel = gi; }
        }
        int i1 = 0, i2 = 0; float m1 = -1e30f, m2 = -1e30f;
#pragma unroll
        for (int gi = 0; gi < 4; ++gi)
#pragma unroll
            for (int k = 0; k < 4; ++k) if (gi == gsel) { const float t = bz[gi * 4 + k]; const int id = gi * 4 + k;
                if (t > m1) { m2 = m1; i2 = i1; m1 = t; i1 = id; } else if (t > m2) { m2 = t; i2 = id; } }
        float s1 = 0.f, s2 = 0.f;
#pragma unroll
        for (int e = 0; e < 16; ++e) { if (e == i1) s1 = s[e]; if (e == i2) s2 = s[e]; }
        const float inv = 1.f / (s1 + s2);
        unsigned* cnt = (unsigned*)(P.ws + WS_CTL) + CW_CNT + layer * 16 * 64;
        int* tok_e = (int*)(P.ws + WS_ROUTE); int* tok_pos = tok_e + 4 * NTOK;
        int* tok_of = tok_e + 6 * NTOK; float* w_of = (float*)(tok_of + 16 * ECAP);
        const int p1 = (int)atomicAdd(&cnt[i1 * 64], 1u), p2 = (int)atomicAdd(&cnt[i2 * 64], 1u);
        tok_e[2 * row] = i1; tok_e[2 * row + 1] = i2; tok_pos[2 * row] = p1; tok_pos[2 * row + 1] = p2;
        tok_of[i1 * ECAP + p1] = row; tok_of[i2 * ECAP + p2] = row; w_of[i1 * ECAP + p1] = s1 * inv; w_of[i2 * ECAP + p2] = s2 * inv;
    }
}
__global__ void __launch_bounds__(256) k_norm2_route(Ptrs P, int layer) {
    const int lane = threadIdx.x & 63, row = blockIdx.x * 4 + (threadIdx.x >> 6);
    f32x4 v[4]; row_load(P.out + (size_t)row * DM, lane, v);
    norm2_route(P, layer, row, lane, v);
}

__device__ __forceinline__ void moe_combine(const Ptrs& P, int layer, int row, int lane, f32x4 (&v)[4]) {
    const unsigned* cnt = (const unsigned*)(P.ws + WS_CTL) + CW_CNT + layer * 16 * 64;
    const int* tok_e = (const int*)(P.ws + WS_ROUTE); const int* tok_pos = tok_e + 4 * NTOK;
    const int e0 = tok_e[2 * row], e1 = tok_e[2 * row + 1];
    int base = 0, rb0 = 0, rb1 = 0;
    for (int i = 0; i < NE; ++i) { if (i == e0) rb0 = base; if (i == e1) rb1 = base; base += ((int)cnt[i * 64] + 255) / 256 * 256; }
    const bf16_t* Y = (const bf16_t*)(P.ws + WS_Y);
    const bf16_t* y0 = Y + (size_t)(rb0 + tok_pos[2 * row]) * DM; const bf16_t* y1 = Y + (size_t)(rb1 + tok_pos[2 * row + 1]) * DM;
    const float* g2 = (const float*)(P.ws + WS_MOD) + (size_t)(layer * 9 + row / SEQ) * 6144 + 5120;
#pragma unroll
    for (int j = 0; j < 4; ++j) { const int c = 256 * j + 4 * lane; const u32x2 a = *(const u32x2*)(y0 + c), bb = *(const u32x2*)(y1 + c); const f32x4 gg = *(const f32x4*)(g2 + c);
        v[j].x += gg.x * (bf2f(a.x & 0xffff) + bf2f(bb.x & 0xffff)); v[j].y += gg.y * (bf2f(a.x >> 16) + bf2f(bb.x >> 16));
        v[j].z += gg.z * (bf2f(a.y & 0xffff) + bf2f(bb.y & 0xffff)); v[j].w += gg.w * (bf2f(a.y >> 16) + bf2f(bb.y >> 16)); }
}
__global__ void __launch_bounds__(256) k_combine_norm1(Ptrs P) {
    const int lane = threadIdx.x & 63, row = blockIdx.x * 4 + (threadIdx.x >> 6);
    f32x4 v[4]; row_load(P.out + (size_t)row * DM, lane, v);
    moe_combine(P, 0, row, lane, v);
#pragma unroll
    for (int j = 0; j < 4; ++j) *(f32x4*)(P.out + (size_t)row * DM + 256 * j + 4 * lane) = v[j];
    const float* MOD = (const float*)(P.ws + WS_MOD) + (size_t)(1 * 9 + row / SEQ) * 6144;
    const float rstd = row_rstd(v);
    row_normmod(v, rstd, P.norm_mix_w + DM, MOD + 0, MOD + 1024, lane);
    row_store_bf16((bf16_t*)(P.ws + WS_RA) + (size_t)row * DM, lane, v);
}
__global__ void __launch_bounds__(256) k_pool_norm2_route(Ptrs P) {
    const int lane = threadIdx.x & 63, row = blockIdx.x * 4 + (threadIdx.x >> 6);
    const int b = row / SEQ, pos = row % SEQ;
    const bf16_t* Z = (const bf16_t*)(P.ws + WS_Y);
    f32x4 v[4]; row_load(P.out + (size_t)row * DM, lane, v);
    const float* g1 = (const float*)(P.ws + WS_MOD) + (size_t)(1 * 9 + b) * 6144 + 2048;
#pragma unroll
    for (int j = 0; j < 4; ++j) {
        const int w = 2 << j, left = w / 2, right = w - 1 - left;
        int lo = pos - left; if (lo < 0) lo = 0; int hi = pos + right + 1; if (hi > SEQ) hi = SEQ;
        const int c = 256 * j + 4 * lane;
        f32x4 s = {0.f, 0.f, 0.f, 0.f};
        for (int t = lo; t < hi; ++t) { const u32x2 a = *(const u32x2*)(Z + (size_t)(b * SEQ + t) * DM + c);
            s.x += bf2f(a.x & 0xffff); s.y += bf2f(a.x >> 16); s.z += bf2f(a.y & 0xffff); s.w += bf2f(a.y >> 16); }
        const u32x2 a = *(const u32x2*)(Z + (size_t)row * DM + c);
        const f32x4 zc = {bf2f(a.x & 0xffff), bf2f(a.x >> 16), bf2f(a.y & 0xffff), bf2f(a.y >> 16)};
        const float inv = 1.f / (float)(hi - lo);
        const f32x4 ps = *(const f32x4*)(P.pool_scale + c), gg = *(const f32x4*)(g1 + c);
        v[j] += gg * ps * (s * inv - zc);
    }
#pragma unroll
    for (int j = 0; j < 4; ++j) *(f32x4*)(P.out + (size_t)row * DM + 256 * j + 4 * lane) = v[j];
    norm2_route(P, 1, row, lane, v);
}
__global__ void __launch_bounds__(256) k_final(Ptrs P) {
    const int lane = threadIdx.x & 63, row = blockIdx.x * 4 + (threadIdx.x >> 6);
    f32x4 v[4]; row_load(P.out + (size_t)row * DM, lane, v);
    moe_combine(P, 1, row, lane, v);
    const float rstd = row_rstd(v);
#pragma unroll
    for (int j = 0; j < 4; ++j) { const int c = 256 * j + 4 * lane; const f32x4 w = *(const f32x4*)(P.final_norm_w + c); *(f32x4*)(P.out + (size_t)row * DM + c) = v[j] * rstd * w; }
}


#define LAS __attribute__((address_space(3)))
#define GAS __attribute__((address_space(1)))
constexpr size_t WS_KVS = 8 * MiB;
constexpr size_t WS_WIN = 48 * MiB;
constexpr size_t WS_WOUT = 54 * MiB;
constexpr size_t WS_WPOOL = 56 * MiB;
constexpr size_t WS_WGU = 58 * MiB;
constexpr size_t WS_WD = 122 * MiB;
static_assert(WS_WD + (size_t)2 * 16 * 1024 * 512 * 2 <= WS_RA, "weights below RA");
constexpr int LDS_STAGE = 131072, LDS_MISC = LDS_STAGE, LDS_BYTES = 147456;

namespace pg8 {
constexpr int BM = 256, BK = 64, HALF = 128, HTB = HALF * BK * 2, STAGE_BYTES = 8 * HTB, NXCD = 8, WGM = 8;
__host__ __device__ __forceinline__ int lds_byte(int r, int c) { const int st = (r >> 4) * 2 + (c >> 5), rr = r & 15, cc = c & 31, ob = rr * 64 + cc * 2; return st * 1024 + (ob ^ (((ob >> 9) & 1) << 5)); }
__host__ __device__ __forceinline__ void stage_rc(int b, int& R, int& C) { const int st = b / 1024, sb = b % 1024, swz = sb ^ (((sb >> 9) & 1) << 5); R = (st >> 1) * 16 + swz / 64; C = (st & 1) * 32 + (swz % 64) / 2; }
__host__ __device__ __forceinline__ int perm32(int rho) { const int n = rho >> 4, i = rho & 15; return 8 * (i >> 2) + 4 * n + (i & 3); }
__device__ __forceinline__ unsigned cvt_pk_bf16(float lo, float hi) { unsigned r; asm volatile("v_cvt_pk_bf16_f32 %0, %1, %2" : "=v"(r) : "v"(lo), "v"(hi)); return r; }

template <class Epi, class Sched>
__device__ __forceinline__ void gemm_phase(LAS unsigned char* lds, const bf16_t* Abase, int ldb, int K, const Sched& S, const Epi& E) {
    const int tid = threadIdx.x, wid = __builtin_amdgcn_readfirstlane(tid >> 6), lane = tid & 63, wr = wid >> 2, wc = wid & 3, fr = lane & 15, fq = lane >> 4;
    const int nt = K / BK;
    unsigned voffB[2];
#pragma unroll
    for (int i = 0; i < 2; ++i) { int R_, C_; stage_rc(tid * 16 + i * 8192, R_, C_); const int Rb = Epi::PERM ? ((R_ & ~31) + perm32(R_ & 31)) : R_; voffB[i] = (unsigned)(Rb * ldb + C_) * 2u; }
    const size_t kstep = (size_t)(BK * 2);
    const size_t hstepB = (size_t)HALF * ldb * 2;
    const unsigned ldsw = (unsigned)wid * 1024u;
    const int aoff = lds_byte(wr * 64 + fr, fq * 8), boff = lds_byte(wc * 32 + fr, fq * 8);
#define PG8_SA(b, h) (((b) * 2 + (h)) * HTB)
#define PG8_SB(b, h) ((4 + (b) * 2 + (h)) * HTB)
#define PG8_STAGE(bufoff, gbase, voff) do { _Pragma("unroll") for (int _i = 0; _i < 2; ++_i) \
        __builtin_amdgcn_global_load_lds((const unsigned*)((const char*)(gbase) + (voff)[_i]), (LAS unsigned*)(lds + (bufoff) + ldsw + _i * 8192), 16, 0, 0); } while (0)
#define PG8_LDA(dst, b, h) do { _Pragma("unroll") for (int m = 0; m < 4; ++m) _Pragma("unroll") for (int k = 0; k < 2; ++k) dst[m][k] = *(const LAS bf16x8*)(lds + PG8_SA(b, h) + aoff + m * 2048 + k * 1024); } while (0)
#define PG8_LDB(dst, b, h) do { _Pragma("unroll") for (int n = 0; n < 2; ++n) _Pragma("unroll") for (int k = 0; k < 2; ++k) dst[n][k] = *(const LAS bf16x8*)(lds + PG8_SB(b, h) + boff + n * 2048 + k * 1024); } while (0)
#define PG8_MMA(ai, bj, At, Bt) do { __builtin_amdgcn_s_setprio(1); _Pragma("unroll") for (int m = 0; m < 4; ++m) _Pragma("unroll") for (int n = 0; n < 2; ++n) _Pragma("unroll") for (int k = 0; k < 2; ++k) \
        acc[ai][bj][m][n] = __builtin_amdgcn_mfma_f32_16x16x32_bf16(Bt[n][k], At[m][k], acc[ai][bj][m][n], 0, 0, 0); __builtin_amdgcn_s_setprio(0); } while (0)
#define PG8_WAIT_V(n) asm volatile("s_waitcnt vmcnt(" #n ")" ::: "memory")
#define PG8_WAIT_L(n) asm volatile("s_waitcnt lgkmcnt(" #n ")" ::: "memory")
#define PG8_BAR __builtin_amdgcn_s_barrier()
#define PG8_SCHED __builtin_amdgcn_sched_barrier(0)
    typename Sched::Unit cur, nxt; int ui = 0;
    if (!S.next(0, cur)) return;
    f32x4 acc[2][2][4][2];
#pragma unroll
    for (int a = 0; a < 2; ++a)
#pragma unroll
        for (int b = 0; b < 2; ++b)
#pragma unroll
            for (int m = 0; m < 4; ++m)
#pragma unroll
                for (int n = 0; n < 2; ++n) acc[a][b][m][n] = (f32x4){0.f, 0.f, 0.f, 0.f};
    bf16x8 At[4][2], B0[2][2], B1[2][2];
    unsigned cvA[2][2];
    S.a_offsets(cur, cvA);
    const char* cB = S.b_ptr(cur);
    const char* const cA = (const char*)Abase;
    PG8_STAGE(PG8_SB(0, 0), cB, voffB); PG8_STAGE(PG8_SB(0, 1), cB + hstepB, voffB); PG8_STAGE(PG8_SA(0, 0), cA, cvA[0]); PG8_STAGE(PG8_SA(0, 1), cA, cvA[1]);
    if (wr == 1) PG8_BAR;
    PG8_WAIT_V(2); PG8_BAR;
    PG8_STAGE(PG8_SB(1, 0), cB + kstep, voffB); PG8_STAGE(PG8_SA(1, 0), cA + kstep, cvA[0]); PG8_STAGE(PG8_SB(1, 1), cB + hstepB + kstep, voffB);
    PG8_WAIT_V(6); PG8_BAR;
    for (;;) {
        const bool has_next = S.next(ui + 1, nxt);
        const char* nB = has_next ? S.b_ptr(nxt) : cB;
#pragma unroll 1
        for (int t = 0; t < nt; t += 2) {
            const bool last = (t == nt - 2);
            const char* a1 = cA + (size_t)(t + 1) * kstep;
            const char* a2 = last ? cA : cA + (size_t)(t + 2) * kstep; const char* b2 = last ? nB : cB + (size_t)(t + 2) * kstep;
            const char* a3 = a2 + kstep; const char* b3 = b2 + kstep;
            PG8_LDB(B0, 0, 0); PG8_LDB(B1, 0, 1); PG8_SCHED; PG8_LDA(At, 0, 0); PG8_STAGE(PG8_SA(1, 1), a1, cvA[1]);
            if (last && has_next) S.a_offsets(nxt, cvA);
            PG8_WAIT_V(8); PG8_WAIT_L(0); PG8_BAR; PG8_MMA(0, 0, At, B0); PG8_MMA(0, 1, At, B1); PG8_BAR; PG8_SCHED;
            PG8_LDA(At, 0, 1); PG8_STAGE(PG8_SB(0, 0), b2, voffB); PG8_STAGE(PG8_SB(0, 1), b2 + hstepB, voffB); PG8_STAGE(PG8_SA(0, 0), a2, cvA[0]);
            PG8_WAIT_V(8); PG8_WAIT_L(0); PG8_BAR; PG8_MMA(1, 0, At, B0); PG8_MMA(1, 1, At, B1); PG8_BAR; PG8_SCHED;
            PG8_LDB(B0, 1, 0); PG8_LDB(B1, 1, 1); PG8_SCHED; PG8_LDA(At, 1, 0); PG8_STAGE(PG8_SA(0, 1), a2, cvA[1]);
            PG8_WAIT_V(8); PG8_WAIT_L(0); PG8_BAR; PG8_MMA(0, 0, At, B0); PG8_MMA(0, 1, At, B1); PG8_BAR; PG8_SCHED;
            PG8_LDA(At, 1, 1); PG8_STAGE(PG8_SB(1, 0), b3, voffB); PG8_STAGE(PG8_SB(1, 1), b3 + hstepB, voffB); PG8_STAGE(PG8_SA(1, 0), a3, cvA[0]);
            PG8_WAIT_V(8); PG8_WAIT_L(0); PG8_BAR; PG8_MMA(1, 0, At, B0); PG8_MMA(1, 1, At, B1); PG8_BAR; PG8_SCHED;
        }
        if (wr == 0) PG8_BAR;
        E(acc, cur, wr, wc, fr, fq);
        if (!has_next) break;
#pragma unroll
        for (int a = 0; a < 2; ++a)
#pragma unroll
            for (int b = 0; b < 2; ++b)
#pragma unroll
                for (int m = 0; m < 4; ++m)
#pragma unroll
                    for (int n = 0; n < 2; ++n) acc[a][b][m][n] = (f32x4){0.f, 0.f, 0.f, 0.f};
        cur = nxt; cB = nB; ++ui;
        if (wr == 1) PG8_BAR;
    }
    PG8_WAIT_V(0);
    PG8_BAR;
#undef PG8_SA
#undef PG8_SB
#undef PG8_STAGE
#undef PG8_LDA
#undef PG8_LDB
#undef PG8_MMA
#undef PG8_WAIT_V
#undef PG8_WAIT_L
#undef PG8_BAR
#undef PG8_SCHED
}
}

#define XB_TMO      128
#define XB_XCNT(j)  (256  + 64 * (j))
#define XB_XSUB(j)  (1280 + 64 * (j))
#define XB_XGEN(j)  (2304 + 64 * (j))
#define XB_TOP      3328
#define XB_TOPGEN   3392
#define XCD_BAR_WORDS 3456
#define XB_SPIN_CAP (1u << 18)
constexpr int CW_BAR = 8192;
__device__ __forceinline__ unsigned xb_ld(unsigned* p)              { return __hip_atomic_load(p, __ATOMIC_RELAXED, __HIP_MEMORY_SCOPE_AGENT); }
__device__ __forceinline__ unsigned xb_add(unsigned* p, unsigned v) { return __hip_atomic_fetch_add(p, v, __ATOMIC_RELAXED, __HIP_MEMORY_SCOPE_AGENT); }
__device__ __forceinline__ unsigned xb_xcc_id() { return (unsigned)__builtin_amdgcn_s_getreg((3 << 11) | 20) & 0xFu; }
#define XB_SPIN(cond, bar) do { unsigned _sp = 0; while (cond) { __builtin_amdgcn_s_sleep(1); \
    if ((++_sp & 255u) == 0u) { if (xb_ld(&(bar)[XB_TMO])) break; if (_sp > XB_SPIN_CAP) { atomicAdd(&(bar)[XB_TMO], 1u); break; } } } } while (0)
struct XcdBarrier { unsigned* bar; unsigned x; volatile LAS unsigned* st; };
__device__ __forceinline__ XcdBarrier xcd_barrier_post(unsigned* bar, volatile LAS unsigned* st) {
    XcdBarrier b; b.bar = bar; b.x = xb_xcc_id(); b.st = st;
    if (threadIdx.x == 0) (void)xb_add(&bar[XB_XCNT(b.x)], 1u);
    return b;
}
__device__ __forceinline__ void xcd_barrier_complete(unsigned* bar, unsigned x, unsigned& nloc, unsigned& nx) {
    const unsigned G = gridDim.x * gridDim.y * gridDim.z;
    unsigned sum, cnt, mine, sp = 0u;
    for (;;) {
        sum = 0u; cnt = 0u; mine = 0u;
#pragma unroll
        for (unsigned j = 0; j < 16; ++j) { const unsigned c = xb_ld(&bar[XB_XCNT(j)]); sum += c; cnt += (c > 0u) ? 1u : 0u; mine = (j == x) ? c : mine; }
        if (sum == G) break;
        __builtin_amdgcn_s_sleep(1);
        if ((++sp & 255u) == 0u) { if (xb_ld(&bar[XB_TMO])) break; if (sp > XB_SPIN_CAP) { atomicAdd(&bar[XB_TMO], 1u); break; } }
    }
    nloc = mine > 0u ? mine : 1u; nx = cnt > 0u ? cnt : 1u;
}
__device__ __forceinline__ void xcd_barrier(const XcdBarrier& b) {
    asm volatile("s_waitcnt vmcnt(0)" ::: "memory");
    __syncthreads();
    if (threadIdx.x == 0) {
        unsigned* bar = b.bar;
        __builtin_amdgcn_s_waitcnt(0);
        unsigned nloc = b.st[0], nx = b.st[1];
        if (nloc == 0u) { xcd_barrier_complete(bar, b.x, nloc, nx); b.st[0] = nloc; b.st[1] = nx; }
        const unsigned old = xb_add(&bar[XB_XSUB(b.x)], 1u);
        const unsigned gen = old / nloc;
        if (old + 1u == (gen + 1u) * nloc) {
            __builtin_amdgcn_fence(__ATOMIC_RELEASE, "agent");
            asm volatile("s_waitcnt vmcnt(0)" ::: "memory");
            const unsigned og = xb_add(&bar[XB_TOP], 1u);
            const unsigned tg = og / nx;
            if (og + 1u == (tg + 1u) * nx) xb_add(&bar[XB_TOPGEN], 1u);
            else XB_SPIN(xb_ld(&bar[XB_TOPGEN]) == tg, bar);
            __builtin_amdgcn_fence(__ATOMIC_ACQUIRE, "agent");
            xb_add(&bar[XB_XGEN(b.x)], 1u);
            asm volatile("s_waitcnt vmcnt(0)" ::: "memory");
        } else {
            XB_SPIN(xb_ld(&bar[XB_XGEN(b.x)]) == gen, bar);
            __builtin_amdgcn_fence(__ATOMIC_ACQUIRE, "agent");
            asm volatile("s_waitcnt vmcnt(0)" ::: "memory");
        }
    }
    __syncthreads();
}

__device__ __forceinline__ void p0_transpose_item(const float* W, int ldn, int k0, int n0, bf16_t* WT, int ldt, int drow0, LAS float* scr, int lane) {
#pragma unroll 8
    for (int i = 0; i < 32; ++i) { const int kk = 2 * i + (lane >> 5); scr[kk * 33 + (lane & 31)] = W[(size_t)(k0 + kk) * ldn + n0 + (lane & 31)]; }
    asm volatile("s_waitcnt lgkmcnt(0)" ::: "memory");
    const int c = lane & 7;
#pragma unroll
    for (int j = 0; j < 4; ++j) { const int n = (lane >> 3) + 8 * j; const LAS float* s = scr + (8 * c) * 33 + n;
        u32x4 o; o.x = pk2(s[0 * 33], s[1 * 33]); o.y = pk2(s[2 * 33], s[3 * 33]); o.z = pk2(s[4 * 33], s[5 * 33]); o.w = pk2(s[6 * 33], s[7 * 33]);
        *(u32x4*)(WT + (size_t)(drow0 + n) * ldt + k0 + 8 * c) = o; }
    asm volatile("s_waitcnt lgkmcnt(0)" ::: "memory");
}

__device__ __forceinline__ void stage_rows(int (&sR)[2], int (&sC)[2]) {
    int tid = threadIdx.x; asm volatile("" : "+v"(tid));
#pragma unroll
    for (int i = 0; i < 2; ++i) pg8::stage_rc(tid * 16 + i * 8192, sR[i], sC[i]);
}
struct ProjOrder {
    struct Unit { int pm, pn; };
    int G, c; const bf16_t* WIN;
    __device__ __forceinline__ bool next(int i, Unit& u) const {
        const int L = i * G + c;
        if (L < 768) { const int xcd = L & 7, off = L >> 3; u.pm = 8 * xcd + (off & 7); u.pn = off >> 3; return true; }
        if (L < 824) { const int q = L - 768; u.pm = 64 + q / 7; u.pn = 5 + q % 7; return true; }
        return false;
    }
    __device__ __forceinline__ void a_offsets(const Unit& u, unsigned (&v)[2][2]) const {
        int sR[2], sC[2]; stage_rows(sR, sC);
#pragma unroll
        for (int h = 0; h < 2; ++h)
#pragma unroll
            for (int i = 0; i < 2; ++i) v[h][i] = (unsigned)((u.pm * 256 + h * 128 + sR[i]) * DM + sC[i]) * 2u;
    }
    __device__ __forceinline__ const char* b_ptr(const Unit& u) const { return (const char*)WIN + (size_t)u.pn * 256 * DM * 2; }
};
struct EpiProj {
    static constexpr bool PERM = false;
    bf16_t* PROJ; const float* tab;
    __device__ __forceinline__ void operator()(const f32x4 (&acc)[2][2][4][2], const ProjOrder::Unit& u, int wr, int wc, int fr, int fq) const {
        const int pn = u.pn; const bool ctx = u.pm >= 64;
        const bool rope = !ctx && (pn <= 2 || pn == 5 || pn == 8 || pn == 9);
        const float scale = (pn == 1 || pn == 2) ? 0.125f * LOG2E : (pn == 5 ? 0.125f : 1.f);
#pragma unroll
        for (int ai = 0; ai < 2; ++ai)
#pragma unroll
            for (int m = 0; m < 4; ++m) {
                const int row = u.pm * 256 + ai * 128 + wr * 64 + m * 16 + fr;
                f32x4 cs = {1.f, 1.f, 1.f, 1.f}, sn = {0.f, 0.f, 0.f, 0.f};
                if (rope) { const int t = row & (SEQ - 1); const int pos = (wc & 1) ? (t & 63) : (t >> 6);
                    const f32x4 a = *(const f32x4*)(tab + (pos * 16 + 4 * fq) * 2), b = *(const f32x4*)(tab + (pos * 16 + 4 * fq) * 2 + 4);
                    cs = (f32x4){a.x, a.z, b.x, b.z}; sn = (f32x4){a.y, a.w, b.y, b.w}; }
                bf16_t* rowp = PROJ + (size_t)row * INW + pn * 256 + wc * 32 + 4 * fq;
#pragma unroll
                for (int bj = 0; bj < 2; ++bj) {
                    const f32x4 x1 = acc[ai][bj][m][0], x2 = acc[ai][bj][m][1];
                    const f32x4 o1 = (x1 * cs - x2 * sn) * scale, o2 = (x1 * sn + x2 * cs) * scale;
                    u32x2 w1, w2; w1.x = pg8::cvt_pk_bf16(o1.x, o1.y); w1.y = pg8::cvt_pk_bf16(o1.z, o1.w); w2.x = pg8::cvt_pk_bf16(o2.x, o2.y); w2.y = pg8::cvt_pk_bf16(o2.z, o2.w);
                    *(u32x2*)(rowp + bj * 128) = w1; *(u32x2*)(rowp + bj * 128 + 16) = w2;
                }
            }
    }
};


struct OutOrder {
    struct Unit { int pm, pn; };
    int G, c; const bf16_t* W;
    __device__ __forceinline__ bool next(int i, Unit& u) const { const int L = i * G + c; if (L >= 256) return false; const int xcd = L & 7, off = L >> 3; u.pm = 8 * xcd + (off & 7); u.pn = off >> 3; return true; }
    __device__ __forceinline__ void a_offsets(const Unit& u, unsigned (&v)[2][2]) const {
        int sR[2], sC[2]; stage_rows(sR, sC);
#pragma unroll
        for (int h = 0; h < 2; ++h)
#pragma unroll
            for (int i = 0; i < 2; ++i) v[h][i] = (unsigned)((u.pm * 256 + h * 128 + sR[i]) * DM + sC[i]) * 2u;
    }
    __device__ __forceinline__ const char* b_ptr(const Unit& u) const { return (const char*)W + (size_t)u.pn * 256 * DM * 2; }
};
struct EpiOut {
    static constexpr bool PERM = false;
    const float* x; float* out; const float* g1;
    __device__ __forceinline__ void operator()(const f32x4 (&acc)[2][2][4][2], const OutOrder::Unit& u, int wr, int wc, int fr, int fq) const {
        const int col0 = u.pn * 256 + wc * 32 + 4 * fq;
#pragma unroll
        for (int ai = 0; ai < 2; ++ai)
#pragma unroll
            for (int m = 0; m < 4; ++m) {
                const int row = u.pm * 256 + ai * 128 + wr * 64 + m * 16 + fr; const int b = row >> 11;
                const size_t off = (size_t)row * DM + col0; const float* gp = g1 + (size_t)b * 6144 + col0;
#pragma unroll
                for (int bj = 0; bj < 2; ++bj)
#pragma unroll
                    for (int n = 0; n < 2; ++n) { const int o = bj * 128 + n * 16; *(f32x4*)(out + off + o) = *(const f32x4*)(x + off + o) + *(const f32x4*)(gp + o) * acc[ai][bj][m][n]; }
            }
    }
};
struct PoolOrder {
    struct Unit { int pm, pn; };
    int G, c; const bf16_t* W;
    __device__ __forceinline__ bool next(int i, Unit& u) const { const int L = i * G + c; if (L >= 256) return false; const int xcd = L & 7, off = L >> 3; u.pm = 8 * xcd + (off & 7); u.pn = off >> 3; return true; }
    __device__ __forceinline__ void a_offsets(const Unit& u, unsigned (&v)[2][2]) const {
        int sR[2], sC[2]; stage_rows(sR, sC);
#pragma unroll
        for (int h = 0; h < 2; ++h)
#pragma unroll
            for (int i = 0; i < 2; ++i) v[h][i] = (unsigned)((u.pm * 256 + h * 128 + sR[i]) * DM + u.pn * 256 + sC[i]) * 2u;
    }
    __device__ __forceinline__ const char* b_ptr(const Unit& u) const { return (const char*)W + (size_t)u.pn * 65536 * 2; }
};
template <class U> struct EpiStoreBf16 {
    static constexpr bool PERM = false;
    bf16_t* O; int ldo;
    __device__ __forceinline__ void operator()(const f32x4 (&acc)[2][2][4][2], const U& u, int wr, int wc, int fr, int fq) const {
#pragma unroll
        for (int ai = 0; ai < 2; ++ai)
#pragma unroll
            for (int m = 0; m < 4; ++m) {
                bf16_t* rowp = O + (size_t)(u.orow0() + ai * 128 + wr * 64 + m * 16 + fr) * ldo + u.ocol0() + wc * 32 + 4 * fq;
#pragma unroll
                for (int bj = 0; bj < 2; ++bj)
#pragma unroll
                    for (int n = 0; n < 2; ++n) { const f32x4 v = acc[ai][bj][m][n]; u32x2 w; w.x = pg8::cvt_pk_bf16(v.x, v.y); w.y = pg8::cvt_pk_bf16(v.z, v.w); *(u32x2*)(rowp + bj * 128 + n * 16) = w; }
            }
    }
};
struct PoolUnitView { int pm, pn; __device__ __forceinline__ int orow0() const { return pm * 256; } __device__ __forceinline__ int ocol0() const { return pn * 256; } };
struct EpiPool { static constexpr bool PERM = false; bf16_t* O;
    __device__ __forceinline__ void operator()(const f32x4 (&acc)[2][2][4][2], const PoolOrder::Unit& u, int wr, int wc, int fr, int fq) const { EpiStoreBf16<PoolUnitView> e{O, DM}; e(acc, PoolUnitView{u.pm, u.pn}, wr, wc, fr, fq); } };

struct MoeUnit { int e, t0, rowbase, pn, cnt; __device__ __forceinline__ int orow0() const { return rowbase; } __device__ __forceinline__ int ocol0() const { return pn * 256; } };
__device__ __forceinline__ void moe_setup(volatile LAS unsigned* MISC, const unsigned* cnt) {
    __syncthreads();
    if (threadIdx.x == 0) { unsigned base = 0; for (int e = 0; e < NE; ++e) { const unsigned c = cnt[e * 64]; MISC[16 + e] = base; MISC[33 + e] = c; base += (c + 255u) >> 8; } MISC[32] = base; }
    __syncthreads();
}
template <int GATHER> struct MoeOrderT {
    typedef MoeUnit Unit;
    int G, vcu; volatile LAS unsigned* MISC; const int* tok_of; const bf16_t* W;
    __device__ __forceinline__ bool next(int i, Unit& u) const {
        const int L = i * G + vcu; const int NT = __builtin_amdgcn_readfirstlane((int)MISC[32]); if (L >= 4 * NT) return false;
        const int T = L >> 2; u.pn = L & 3; int e = 0;
#pragma unroll
        for (int k = 1; k < NE; ++k) e = (__builtin_amdgcn_readfirstlane((int)MISC[16 + k]) <= T) ? k : e;
        e = __builtin_amdgcn_readfirstlane(e);
        u.e = e; u.t0 = __builtin_amdgcn_readfirstlane((T - (int)MISC[16 + e]) * 256); u.rowbase = T * 256; u.cnt = __builtin_amdgcn_readfirstlane((int)MISC[33 + e]); return true;
    }
    __device__ __forceinline__ void a_offsets(const Unit& u, unsigned (&v)[2][2]) const {
        int sR[2], sC[2]; stage_rows(sR, sC);
#pragma unroll
        for (int h = 0; h < 2; ++h)
#pragma unroll
            for (int i = 0; i < 2; ++i) {
                if (GATHER) { int r = u.t0 + h * 128 + sR[i]; if (r >= u.cnt) r = 0; const int tok = tok_of[u.e * ECAP + r]; v[h][i] = (unsigned)(tok * DM + sC[i]) * 2u; }
                else v[h][i] = (unsigned)((u.rowbase + h * 128 + sR[i]) * DE + sC[i]) * 2u;
            }
    }
    __device__ __forceinline__ const char* b_ptr(const Unit& u) const { return (const char*)W + ((size_t)u.e * 1024 + u.pn * 256) * (GATHER ? DM : DE) * 2; }
};
struct EpiGateUp {
    static constexpr bool PERM = false;
    bf16_t* HID; const float* w_of;
    __device__ __forceinline__ void operator()(const f32x4 (&acc)[2][2][4][2], const MoeUnit& u, int wr, int wc, int fr, int fq) const {
#pragma unroll
        for (int ai = 0; ai < 2; ++ai)
#pragma unroll
            for (int m = 0; m < 4; ++m) {
                const int rl = ai * 128 + wr * 64 + m * 16 + fr; const int pos = u.t0 + rl;
                const float w = pos < u.cnt ? w_of[u.e * ECAP + pos] : 0.f;
                bf16_t* rowp = HID + (size_t)(u.rowbase + rl) * DE + u.pn * 128 + wc * 32 + 4 * fq;
#pragma unroll
                for (int n = 0; n < 2; ++n) { const f32x4 g = acc[ai][0][m][n], up = acc[ai][1][m][n]; f32x4 h;
#pragma unroll
                    for (int k = 0; k < 4; ++k) h[k] = g[k] / (1.f + __expf(-g[k])) * up[k] * w;
                    u32x2 o; o.x = pg8::cvt_pk_bf16(h.x, h.y); o.y = pg8::cvt_pk_bf16(h.z, h.w); *(u32x2*)(rowp + n * 16) = o; }
            }
    }
};
struct EpiDown { static constexpr bool PERM = false; bf16_t* Y;
    __device__ __forceinline__ void operator()(const f32x4 (&acc)[2][2][4][2], const MoeUnit& u, int wr, int wc, int fr, int fq) const { EpiStoreBf16<MoeUnit> e{Y, DM}; e(acc, u, wr, wc, fr, fq); } };

template <int LAYER> __device__ __forceinline__ void moe_gateup_phase(LAS unsigned char* lds, volatile LAS unsigned* MISC, unsigned char* ws, int G, int vcu) {
    const int* tok_of = (const int*)(ws + WS_ROUTE) + 6 * NTOK; const float* w_of = (const float*)(tok_of + 16 * ECAP);
    moe_setup(MISC, (const unsigned*)(ws + WS_CTL) + CW_CNT + LAYER * 16 * 64);
    MoeOrderT<1> S{G, vcu, MISC, tok_of, (const bf16_t*)(ws + WS_WGU) + (size_t)LAYER * 16 * 1024 * 1024};
    EpiGateUp E{(bf16_t*)(ws + WS_HID), w_of};
    pg8::gemm_phase<EpiGateUp, MoeOrderT<1>>(lds, (const bf16_t*)(ws + WS_RA), DM, DM, S, E);
}
template <int LAYER> __device__ __forceinline__ void moe_down_phase(LAS unsigned char* lds, volatile LAS unsigned* MISC, unsigned char* ws, int G, int vcu) {
    moe_setup(MISC, (const unsigned*)(ws + WS_CTL) + CW_CNT + LAYER * 16 * 64);
    MoeOrderT<0> S{G, vcu, MISC, nullptr, (const bf16_t*)(ws + WS_WD) + (size_t)LAYER * 16 * 1024 * 512};
    EpiDown E{(bf16_t*)(ws + WS_Y)};
    pg8::gemm_phase<EpiDown, MoeOrderT<0>>(lds, (const bf16_t*)(ws + WS_HID), DE, DE, S, E);
}

namespace att {
typedef float f32x16 __attribute__((ext_vector_type(16)));
typedef short s16x4 __attribute__((ext_vector_type(4)));
#define ATT_KSWZ(row, colB) ((row) * 256 + ((colB) ^ (((row) & 7) << 4)))
#define ATT_SBAR() __builtin_amdgcn_sched_barrier(0)
constexpr float THR = 8.f;
__device__ __forceinline__ int crow(int r, int hi) { return (r & 3) + 8 * (r >> 2) + 4 * hi; }
__device__ __forceinline__ unsigned cvtpk(float lo, float hi) { unsigned r; asm volatile("v_cvt_pk_bf16_f32 %0, %1, %2" : "=v"(r) : "v"(lo), "v"(hi)); return r; }
__device__ __forceinline__ void partialSM(f32x16& p0, f32x16& p1, float& m_reg, float& mn, float& alpha) {
    float pmax = p0[0];
#pragma unroll
    for (int r = 1; r < 16; ++r) pmax = fmaxf(pmax, p0[r]);
#pragma unroll
    for (int r = 0; r < 16; ++r) pmax = fmaxf(pmax, p1[r]);
    { auto rr = __builtin_amdgcn_permlane32_swap(__float_as_uint(pmax), __float_as_uint(pmax), false, false); pmax = fmaxf(__uint_as_float(rr[0]), __uint_as_float(rr[1])); }
    if (__builtin_expect(__all(pmax - m_reg <= THR), 1)) { mn = m_reg; alpha = 1.f; }
    else { mn = fmaxf(m_reg, pmax); alpha = __builtin_amdgcn_exp2f(m_reg - mn); m_reg = mn; }
#pragma unroll
    for (int r = 0; r < 16; ++r) { p0[r] -= mn; p1[r] -= mn; }
#pragma unroll
    for (int r = 0; r < 16; ++r) p0[r] = __builtin_amdgcn_exp2f(p0[r]);
}
__device__ __forceinline__ void finishSM(f32x16& p0, f32x16& p1, float alpha, float& l_reg, bf16x8& pa0, bf16x8& pa1, bf16x8& pa2, bf16x8& pa3) {
#pragma unroll
    for (int r = 0; r < 16; ++r) p1[r] = __builtin_amdgcn_exp2f(p1[r]);
    float ps = 0.f;
#pragma unroll
    for (int r = 0; r < 16; ++r) ps += p0[r];
#pragma unroll
    for (int r = 0; r < 16; ++r) ps += p1[r];
    { auto rr = __builtin_amdgcn_permlane32_swap(__float_as_uint(ps), __float_as_uint(ps), false, false); ps = __uint_as_float(rr[0]) + __uint_as_float(rr[1]); }
    l_reg = l_reg * alpha + ps;
#define ATT_PK4(P, BASE, OUT) do { unsigned a0 = cvtpk(P[BASE + 0], P[BASE + 1]), a1 = cvtpk(P[BASE + 2], P[BASE + 3]);   \
    unsigned b0 = cvtpk(P[BASE + 4], P[BASE + 5]), b1 = cvtpk(P[BASE + 6], P[BASE + 7]);                              \
    auto r0 = __builtin_amdgcn_permlane32_swap(a0, b0, false, false); auto r1 = __builtin_amdgcn_permlane32_swap(a1, b1, false, false); \
    u32x4 w = {r0[0], r1[0], r0[1], r1[1]}; OUT = __builtin_bit_cast(bf16x8, w); } while (0)
    ATT_PK4(p0, 0, pa0); ATT_PK4(p0, 8, pa1); ATT_PK4(p1, 0, pa2); ATT_PK4(p1, 8, pa3);
#undef ATT_PK4
}
__device__ __forceinline__ void qkt(f32x16& p0, f32x16& p1, const LAS unsigned char* Ks, const bf16x8 (&qr)[4], int r32, int hi, int kc) {
    p0 = f32x16{}; p1 = f32x16{};
#pragma unroll
    for (int d0 = 0; d0 < 4; ++d0) { const int cb = kc + (d0 * 16 + hi * 8) * 2;
        const bf16x8 b0 = *(const LAS bf16x8*)(Ks + ATT_KSWZ(r32, cb));
        const bf16x8 b1 = *(const LAS bf16x8*)(Ks + ATT_KSWZ(32 + r32, cb));
        p0 = __builtin_amdgcn_mfma_f32_32x32x16_bf16(b0, qr[d0], p0, 0, 0, 0);
        p1 = __builtin_amdgcn_mfma_f32_32x32x16_bf16(b1, qr[d0], p1, 0, 0, 0); }
}
__device__ __forceinline__ int v_st(int k, int c) { const int kk = (k & ~0xC) | ((k & 4) << 1) | ((k & 8) >> 1); return ((kk >> 3) * 4 + (c >> 5)) * 512 + ((kk & 7) * 32 + (c & 31)) * 2; }
__device__ __forceinline__ int v_rd_base(int lane) { return ((lane & 3) << 3) | (((lane >> 2) & 3) << 6) | (((lane >> 4) & 1) << 5) | (((lane >> 5) & 1) << 8); }
constexpr int v_rd_off(int d0, int ks, int half) { return d0 * 512 + ks * 4096 + half * 2048; }
template <int OFF> __device__ __forceinline__ s16x4 tr_read(int vb) { s16x4 r; asm volatile("ds_read_b64_tr_b16 %0, %1 offset:%2" : "=&v"(r) : "v"(vb), "i"(OFF) : "memory"); return r; }
template <int D0> __device__ __forceinline__ void pv_one(f32x16& od, int vb, bf16x8 pa0, bf16x8 pa1, bf16x8 pa2, bf16x8 pa3) {
    const s16x4 l0 = tr_read<v_rd_off(D0, 0, 0)>(vb), h0 = tr_read<v_rd_off(D0, 0, 1)>(vb), l1 = tr_read<v_rd_off(D0, 1, 0)>(vb), h1 = tr_read<v_rd_off(D0, 1, 1)>(vb);
    const s16x4 l2 = tr_read<v_rd_off(D0, 2, 0)>(vb), h2 = tr_read<v_rd_off(D0, 2, 1)>(vb), l3 = tr_read<v_rd_off(D0, 3, 0)>(vb), h3 = tr_read<v_rd_off(D0, 3, 1)>(vb);
    asm volatile("s_waitcnt lgkmcnt(0)" ::: "memory"); ATT_SBAR();
#define ATT_PK(L, H) (bf16x8){L[0], L[1], L[2], L[3], H[0], H[1], H[2], H[3]}
    od = __builtin_amdgcn_mfma_f32_32x32x16_bf16(pa0, ATT_PK(l0, h0), od, 0, 0, 0);
    od = __builtin_amdgcn_mfma_f32_32x32x16_bf16(pa1, ATT_PK(l1, h1), od, 0, 0, 0);
    od = __builtin_amdgcn_mfma_f32_32x32x16_bf16(pa2, ATT_PK(l2, h2), od, 0, 0, 0);
    od = __builtin_amdgcn_mfma_f32_32x32x16_bf16(pa3, ATT_PK(l3, h3), od, 0, 0, 0);
#undef ATT_PK
}
__device__ __forceinline__ void pv_d0(f32x16 (&o)[4], int vb, bf16x8 pa0, bf16x8 pa1, bf16x8 pa2, bf16x8 pa3) {
    pv_one<0>(o[0], vb, pa0, pa1, pa2, pa3); pv_one<1>(o[1], vb, pa0, pa1, pa2, pa3); pv_one<2>(o[2], vb, pa0, pa1, pa2, pa3); pv_one<3>(o[3], vb, pa0, pa1, pa2, pa3);
}
constexpr int NT = 36, SHM_V = 16384, SHM_K = 16384, OFF_K = 2 * SHM_V, OFF_WS = 67584;
struct Stage { bf16x8 vs0, vs1, ks0, ks1; };

__device__ __forceinline__ void attn_unit(LAS unsigned char* lds, const bf16_t* __restrict__ PROJ, bf16_t* __restrict__ MIX, const float* __restrict__ subln, float lam, int b, int h, int qb) {
    const int tid = threadIdx.x, wid = __builtin_amdgcn_readfirstlane(tid >> 6), lane = tid & 63, r32 = lane & 31, hi = lane >> 5;
    const int c = wid >> 2, wq = wid & 3, kc = c * 128;
    LAS unsigned char* V_lds = lds; LAS unsigned char* K_lds = lds + OFF_K;
    LAS float* wsf = (LAS float*)(lds + OFF_WS) + wid * 64; LAS float* li_l = wsf; LAS float* al_l = wsf + 32;
    const size_t row0 = (size_t)b * SEQ + (size_t)qb * 128;
    float m_reg = -1e30f, l_reg = 0.f; f32x16 o[4] = {}; bf16x8 qr[4];
    const bf16_t* Qw = PROJ + (row0 + wq * 32 + r32) * INW + C_DQ + h * 128 + c * 64 + hi * 8;
#pragma unroll
    for (int d0 = 0; d0 < 4; ++d0) qr[d0] = *(const bf16x8*)(Qw + d0 * 16);
    const int sr = tid >> 4, sc = (tid & 15) * 8;
    const int vst0 = v_st(sr, sc), vst1 = v_st(32 + sr, sc), kst0 = ATT_KSWZ(sr, sc * 2), kst1 = ATT_KSWZ(32 + sr, sc * 2);
    const int vb0 = (int)(uintptr_t)V_lds + v_rd_base(lane);
    const bf16_t* ctxp = PROJ + (size_t)(NTOK + b * CTXL) * INW + h * 128 + sc;
    const bf16_t* latp = PROJ + (size_t)(b * SEQ) * INW + h * 128 + sc;
    Stage sg[2];
#define ATT_SLOAD(i, t) do { const bf16_t* rp_ = ((t) < 4) ? ctxp + (size_t)(t) * 64 * INW : latp + (size_t)((t) - 4) * 64 * INW; \
    sg[i].vs0 = *(const bf16x8*)(rp_ + (size_t)sr * INW + C_DV); sg[i].vs1 = *(const bf16x8*)(rp_ + (size_t)(32 + sr) * INW + C_DV); \
    sg[i].ks0 = *(const bf16x8*)(rp_ + (size_t)sr * INW + C_DK); sg[i].ks1 = *(const bf16x8*)(rp_ + (size_t)(32 + sr) * INW + C_DK); } while (0)
#define ATT_SWRITE(bf, i) do { *(LAS bf16x8*)(V_lds + (bf) * SHM_V + vst0) = sg[i].vs0; *(LAS bf16x8*)(V_lds + (bf) * SHM_V + vst1) = sg[i].vs1; \
    *(LAS bf16x8*)(K_lds + (bf) * SHM_K + kst0) = sg[i].ks0; *(LAS bf16x8*)(K_lds + (bf) * SHM_K + kst1) = sg[i].ks1; } while (0)
#define ATT_SWAIT() asm volatile("s_waitcnt vmcnt(4)" ::: "memory")
#define ATT_RESC(a) do { if (__any((a) < 1.f)) { if (hi == 0) al_l[r32] = (a); asm volatile("s_waitcnt lgkmcnt(0)" ::: "memory"); \
    _Pragma("unroll") for (int d = 0; d < 4; ++d) _Pragma("unroll") for (int r = 0; r < 16; ++r) o[d][r] *= al_l[crow(r, hi)]; } } while (0)
    f32x16 pA0, pA1, pB0, pB1; float mnA, mnB, alA, alB; bf16x8 pa0, pa1, pa2, pa3;
    ATT_SLOAD(0, 0); asm volatile("s_waitcnt vmcnt(0)" ::: "memory"); ATT_SWRITE(0, 0); __syncthreads();
    qkt(pA0, pA1, K_lds, qr, r32, hi, kc); partialSM(pA0, pA1, m_reg, mnA, alA);
    ATT_SLOAD(1, 1); ATT_SLOAD(0, 2);
    ATT_SWAIT(); ATT_SWRITE(1, 1); __syncthreads();
    for (int j = 1; j + 1 < NT; j += 2) {
        ATT_SBAR(); qkt(pB0, pB1, K_lds + SHM_K, qr, r32, hi, kc);
        finishSM(pA0, pA1, alA, l_reg, pa0, pa1, pa2, pa3); ATT_SBAR();
        ATT_SLOAD(1, j + 2); ATT_SBAR();
        pv_d0(o, vb0, pa0, pa1, pa2, pa3); partialSM(pB0, pB1, m_reg, mnB, alB);
        __syncthreads(); ATT_SWAIT(); ATT_SWRITE(0, 0);
        ATT_RESC(alB); __syncthreads();
        ATT_SBAR(); qkt(pA0, pA1, K_lds, qr, r32, hi, kc);
        finishSM(pB0, pB1, alB, l_reg, pa0, pa1, pa2, pa3); ATT_SBAR();
        if (j + 3 < NT) ATT_SLOAD(0, j + 3); ATT_SBAR();
        pv_d0(o, vb0 + SHM_V, pa0, pa1, pa2, pa3); partialSM(pA0, pA1, m_reg, mnA, alA);
        __syncthreads(); ATT_SWAIT(); ATT_SWRITE(1, 1);
        ATT_RESC(alA); __syncthreads();
    }
    ATT_SBAR(); qkt(pB0, pB1, K_lds + SHM_K, qr, r32, hi, kc);
    finishSM(pA0, pA1, alA, l_reg, pa0, pa1, pa2, pa3); ATT_SBAR();
    pv_d0(o, vb0, pa0, pa1, pa2, pa3); partialSM(pB0, pB1, m_reg, mnB, alB);
    __syncthreads(); ATT_RESC(alB);
    finishSM(pB0, pB1, alB, l_reg, pa0, pa1, pa2, pa3); ATT_SBAR();
    pv_d0(o, vb0 + SHM_V, pa0, pa1, pa2, pa3);
    if (hi == 0) li_l[r32] = l_reg; asm volatile("s_waitcnt lgkmcnt(0)" ::: "memory");
    float rli[16];
    const float fsc = c ? lam : 1.f;
#pragma unroll
    for (int r = 0; r < 16; ++r) rli[r] = __builtin_amdgcn_rcpf(li_l[crow(r, hi)]) * fsc;
    __syncthreads();
    LAS float* OB = (LAS float*)lds;
    if (c == 1) {
#pragma unroll
        for (int r = 0; r < 16; ++r)
#pragma unroll
            for (int d0 = 0; d0 < 4; ++d0) OB[(wq * 32 + crow(r, hi)) * 132 + d0 * 32 + r32] = o[d0][r] * rli[r];
    }
    __syncthreads();
    if (c == 0) {
#pragma unroll
        for (int r = 0; r < 16; ++r)
#pragma unroll
            for (int d0 = 0; d0 < 4; ++d0) { LAS float* p = OB + (wq * 32 + crow(r, hi)) * 132 + d0 * 32 + r32; *p = o[d0][r] * rli[r] - *p; }
    }
    __syncthreads();
    {
        const int row = tid >> 2, qd = tid & 3;
        f32x4 x[8]; float ss = 0.f;
#pragma unroll
        for (int k = 0; k < 8; ++k) { x[k] = *(const LAS f32x4*)(OB + row * 132 + qd * 32 + 4 * k); ss += (x[k].x * x[k].x + x[k].y * x[k].y) + (x[k].z * x[k].z + x[k].w * x[k].w); }
        ss += __shfl_xor(ss, 1); ss += __shfl_xor(ss, 2);
        const float rs = rsqrtf(ss * (1.f / 128.f) + EPS) * 0.8f;
        bf16_t* dst = MIX + (row0 + row) * DM + 512 + h * 128 + qd * 32;
#pragma unroll
        for (int k = 0; k < 4; ++k) { const f32x4 w0 = *(const f32x4*)(subln + qd * 32 + 8 * k), w1 = *(const f32x4*)(subln + qd * 32 + 8 * k + 4);
            const f32x4 a = x[2 * k] * rs * w0, bq = x[2 * k + 1] * rs * w1;
            u32x4 w; w.x = cvtpk(a.x, a.y); w.y = cvtpk(a.z, a.w); w.z = cvtpk(bq.x, bq.y); w.w = cvtpk(bq.z, bq.w);
            *(u32x4*)(dst + 8 * k) = w; }
    }
    __syncthreads();
#undef ATT_SLOAD
#undef ATT_SWRITE
#undef ATT_SWAIT
#undef ATT_RESC
}
}

namespace ret {
typedef short s16x4 __attribute__((ext_vector_type(4)));
constexpr int RS_K = 160, RS_V = 288, RS_S = 160;
constexpr int L_KF = 0, L_KB = 20480, L_V = 40960;
__device__ __forceinline__ s16x4 trr(const LAS unsigned char* p) { typedef short v4i16_t __attribute__((ext_vector_type(4))); return __builtin_bit_cast(s16x4, __builtin_amdgcn_ds_read_tr16_b64_v4i16((LAS v4i16_t*)p)); }
__device__ __forceinline__ bf16x8 cat(s16x4 a, s16x4 b) { return (bf16x8){a[0], a[1], a[2], a[3], b[0], b[1], b[2], b[3]}; }
__device__ __forceinline__ size_t xrow0(int b, int x) { return x < 2 ? (size_t)(NTOK + b * CTXL + 128 * x) : (size_t)(b * SEQ + 128 * (x - 2)); }

__device__ __forceinline__ void summary_unit(LAS unsigned char* lds, const bf16_t* __restrict__ PROJ, float* __restrict__ KVS, const float* __restrict__ ldec, int b, int h, int x) {
    const int tid = threadIdx.x, wid = __builtin_amdgcn_readfirstlane(tid >> 6), lane = tid & 63, i16 = lane & 15, g = lane >> 4;
    const float ld0 = ldec[h], ld1 = ldec[4 + h];
    const size_t R0 = xrow0(b, x);
#pragma unroll
    for (int it = 0; it < 2; ++it) { const int q = tid + 512 * it, a = q >> 3, ch = q & 7;
        const u32x4 u = *(const u32x4*)(PROJ + (R0 + a) * INW + C_RK + h * 64 + ch * 8);
        const float df = __expf(ld0 * (float)(127 - a)), db = __expf(ld1 * (float)a);
        u32x4 of, ob;
#pragma unroll
        for (int k = 0; k < 4; ++k) { const float lo = bf2f(u[k] & 0xffff), hi = bf2f(u[k] >> 16); of[k] = pg8::cvt_pk_bf16(lo * df, hi * df); ob[k] = pg8::cvt_pk_bf16(lo * db, hi * db); }
        *(LAS u32x4*)(lds + L_KF + a * RS_K + ch * 16) = of; *(LAS u32x4*)(lds + L_KB + a * RS_K + ch * 16) = ob; }
#pragma unroll
    for (int it = 0; it < 4; ++it) { const int q = tid + 512 * it, a = q >> 4, ch = q & 15;
        *(LAS u32x4*)(lds + L_V + a * RS_V + ch * 16) = *(const u32x4*)(PROJ + (R0 + a) * INW + C_RV + h * 128 + ch * 8); }
    __syncthreads();
    const int dir = wid >> 2, mb = wid & 3;
    const LAS unsigned char* Kd = lds + (dir ? L_KB : L_KF) + (4 * g + (i16 >> 2)) * RS_K + (16 * mb + 4 * (i16 & 3)) * 2;
    const LAS unsigned char* Vd = lds + L_V + (4 * g + (i16 >> 2)) * RS_V + (4 * (i16 & 3)) * 2;
    f32x4 acc[8];
#pragma unroll
    for (int nb = 0; nb < 8; ++nb) acc[nb] = (f32x4){0.f, 0.f, 0.f, 0.f};
#pragma unroll
    for (int ks = 0; ks < 4; ++ks) {
        const bf16x8 af = cat(trr(Kd + 32 * ks * RS_K), trr(Kd + (32 * ks + 16) * RS_K));
#pragma unroll
        for (int nb = 0; nb < 8; ++nb) { const bf16x8 bfv = cat(trr(Vd + 32 * ks * RS_V + 32 * nb), trr(Vd + (32 * ks + 16) * RS_V + 32 * nb));
            acc[nb] = __builtin_amdgcn_mfma_f32_16x16x32_bf16(af, bfv, acc[nb], 0, 0, 0); }
    }
    float* dst = KVS + ((((size_t)(b * 4 + h) * 18 + x) * 2 + dir) * 64 + 16 * mb + 4 * g) * 128 + i16;
#pragma unroll
    for (int nb = 0; nb < 8; ++nb)
#pragma unroll
        for (int r = 0; r < 4; ++r) dst[r * 128 + 16 * nb] = acc[nb][r];
    __syncthreads();
}

__device__ __forceinline__ void output_unit(LAS unsigned char* lds, const bf16_t* __restrict__ PROJ, const float* __restrict__ KVS, bf16_t* __restrict__ MIX, const float* __restrict__ ldec, int b, int h, int ci) {
    const int tid = threadIdx.x, wid = __builtin_amdgcn_readfirstlane(tid >> 6), lane = tid & 63, i16 = lane & 15, g = lane >> 4;
    const float ld0 = ldec[h], ld1 = ldec[4 + h];
    const size_t R0 = (size_t)b * SEQ + 128 * ci;
    {
        const int dir = tid >> 8, db = (tid >> 5) & 7, eq = tid & 31;
        f32x4 st[8];
#pragma unroll
        for (int dd = 0; dd < 8; ++dd) st[dd] = (f32x4){0.f, 0.f, 0.f, 0.f};
        const float* base = KVS + ((size_t)(b * 4 + h) * 18 * 2 + dir) * 8192 + (size_t)(8 * db) * 128 + 4 * eq;
        const int nterm = dir ? 17 - ci : 2 + ci;
        for (int t = 0; t < nterm; ++t) {
            int x; float f;
            if (dir == 0) { x = t; f = __expf(ld0 * 128.f * (float)(1 + ci - t)); }
            else { const int y = ci + 1 + t; x = y < 16 ? 2 + y : y - 16; f = __expf(ld1 * 128.f * (float)t); }
            const float* src = base + (size_t)x * 2 * 8192;
#pragma unroll
            for (int dd = 0; dd < 8; ++dd) st[dd] += *(const f32x4*)(src + dd * 128) * f;
        }
#pragma unroll
        for (int k = 0; k < 4; ++k) { u32x4 w; w.x = pg8::cvt_pk_bf16(st[0][k], st[1][k]); w.y = pg8::cvt_pk_bf16(st[2][k], st[3][k]); w.z = pg8::cvt_pk_bf16(st[4][k], st[5][k]); w.w = pg8::cvt_pk_bf16(st[6][k], st[7][k]);
            *(LAS u32x4*)(lds + dir * 20480 + (4 * eq + k) * RS_S + db * 16) = w; }
    }
#pragma unroll
    for (int it = 0; it < 4; ++it) { const int q = tid + 512 * it, a = q >> 4, ch = q & 15;
        *(LAS u32x4*)(lds + L_V + a * RS_V + ch * 16) = *(const u32x4*)(PROJ + (R0 + a) * INW + C_RV + h * 128 + ch * 8); }
    __syncthreads();
    const int qa = 16 * wid + i16;
    bf16x8 qf[2];
#pragma unroll
    for (int ks = 0; ks < 2; ++ks) qf[ks] = *(const bf16x8*)(PROJ + (R0 + qa) * INW + C_RQ + h * 64 + 32 * ks + 8 * g);
    f32x4 o[8];
    {
        const float df = __expf(ld0 * (float)(qa + 1)), db = __expf(ld1 * (float)(128 - qa));
        const LAS unsigned char* sp = lds + i16 * RS_S + 16 * g;
#pragma unroll
        for (int eb = 0; eb < 8; ++eb) {
            f32x4 af = {0.f, 0.f, 0.f, 0.f}, ab = {0.f, 0.f, 0.f, 0.f};
#pragma unroll
            for (int ks = 0; ks < 2; ++ks) {
                const bf16x8 sf = *(const LAS bf16x8*)(sp + 16 * eb * RS_S + 64 * ks), sb = *(const LAS bf16x8*)(sp + 20480 + 16 * eb * RS_S + 64 * ks);
                af = __builtin_amdgcn_mfma_f32_16x16x32_bf16(sf, qf[ks], af, 0, 0, 0); ab = __builtin_amdgcn_mfma_f32_16x16x32_bf16(sb, qf[ks], ab, 0, 0, 0); }
            o[eb] = af * df + ab * db;
        }
    }
    f32x4 sacc[8];
#pragma unroll
    for (int kb = 0; kb < 8; ++kb) { sacc[kb] = (f32x4){0.f, 0.f, 0.f, 0.f};
#pragma unroll
        for (int ks = 0; ks < 2; ++ks) { const bf16x8 kf = *(const bf16x8*)(PROJ + (R0 + 16 * kb + i16) * INW + C_RK + h * 64 + 32 * ks + 8 * g);
            sacc[kb] = __builtin_amdgcn_mfma_f32_16x16x32_bf16(kf, qf[ks], sacc[kb], 0, 0, 0); } }
#pragma unroll
    for (int kb = 0; kb < 8; ++kb)
#pragma unroll
        for (int r = 0; r < 4; ++r) { const int d = qa - (16 * kb + 4 * g + r); const float wgt = d > 0 ? __expf(ld0 * (float)d) : (d < 0 ? __expf(ld1 * (float)(-d)) : 2.f); sacc[kb][r] *= wgt; }
    const LAS unsigned char* Vd = lds + L_V + (4 * g + (i16 >> 2)) * RS_V + (4 * (i16 & 3)) * 2;
#pragma unroll
    for (int s4 = 0; s4 < 4; ++s4) {
        u32x4 pw; pw.x = pg8::cvt_pk_bf16(sacc[2 * s4][0], sacc[2 * s4][1]); pw.y = pg8::cvt_pk_bf16(sacc[2 * s4][2], sacc[2 * s4][3]);
        pw.z = pg8::cvt_pk_bf16(sacc[2 * s4 + 1][0], sacc[2 * s4 + 1][1]); pw.w = pg8::cvt_pk_bf16(sacc[2 * s4 + 1][2], sacc[2 * s4 + 1][3]);
        const bf16x8 pf = __builtin_bit_cast(bf16x8, pw);
#pragma unroll
        for (int eb = 0; eb < 8; ++eb) { const bf16x8 vf = cat(trr(Vd + 32 * s4 * RS_V + 32 * eb), trr(Vd + (32 * s4 + 16) * RS_V + 32 * eb));
            o[eb] = __builtin_amdgcn_mfma_f32_16x16x32_bf16(vf, pf, o[eb], 0, 0, 0); }
    }
    float ss = 0.f;
#pragma unroll
    for (int eb = 0; eb < 8; ++eb) ss += (o[eb][0] * o[eb][0] + o[eb][1] * o[eb][1]) + (o[eb][2] * o[eb][2] + o[eb][3] * o[eb][3]);
    ss += __shfl_xor(ss, 16); ss += __shfl_xor(ss, 32);
    const float rs = rsqrtf(ss * (1.f / 128.f) + EPS);
    const bf16_t* gp = PROJ + (R0 + qa) * INW + C_RG + h * 128 + 4 * g;
    bf16_t* mp = MIX + (R0 + qa) * DM + h * 128 + 4 * g;
#pragma unroll
    for (int eb = 0; eb < 8; ++eb) { const u32x2 gu = *(const u32x2*)(gp + 16 * eb);
        const float g0 = bf2f(gu.x & 0xffff), g1 = bf2f(gu.x >> 16), g2 = bf2f(gu.y & 0xffff), g3 = bf2f(gu.y >> 16);
        u32x2 w; w.x = pg8::cvt_pk_bf16(o[eb][0] * rs * silu_f(g0), o[eb][1] * rs * silu_f(g1)); w.y = pg8::cvt_pk_bf16(o[eb][2] * rs * silu_f(g2), o[eb][3] * rs * silu_f(g3));
        *(u32x2*)(mp + 16 * eb) = w; }
    __syncthreads();
}
}

__device__ __forceinline__ void rows_norm2_route0(const Ptrs& P, int gw, int NGW, int lane) {
    for (int row = gw; row < NTOK; row += NGW) { f32x4 v[4]; row_load(P.out + (size_t)row * DM, lane, v); norm2_route(P, 0, row, lane, v); }
}
__device__ __forceinline__ void rows_combine_norm1(const Ptrs& P, int gw, int NGW, int lane) {
    for (int row = gw; row < NTOK; row += NGW) {
        f32x4 v[4]; row_load(P.out + (size_t)row * DM, lane, v);
        moe_combine(P, 0, row, lane, v);
#pragma unroll
        for (int j = 0; j < 4; ++j) *(f32x4*)(P.out + (size_t)row * DM + 256 * j + 4 * lane) = v[j];
        const float* MOD = (const float*)(P.ws + WS_MOD) + (size_t)(1 * 9 + row / SEQ) * 6144;
        const float rstd = row_rstd(v);
        row_normmod(v, rstd, P.norm_mix_w + DM, MOD + 0, MOD + 1024, lane);
        row_store_bf16((bf16_t*)(P.ws + WS_RA) + (size_t)row * DM, lane, v);
    }
}
__device__ __forceinline__ void rows_pool_norm2_route1(const Ptrs& P, int gw, int NGW, int lane) {
    const bf16_t* Z = (const bf16_t*)(P.ws + WS_Y);
    for (int row = gw; row < NTOK; row += NGW) {
        const int b = row / SEQ, pos = row % SEQ;
        f32x4 v[4]; row_load(P.out + (size_t)row * DM, lane, v);
        const float* g1 = (const float*)(P.ws + WS_MOD) + (size_t)(1 * 9 + b) * 6144 + 2048;
#pragma unroll
        for (int j = 0; j < 4; ++j) {
            const int w = 2 << j, left = w / 2, right = w - 1 - left;
            int lo = pos - left; if (lo < 0) lo = 0; int hi = pos + right + 1; if (hi > SEQ) hi = SEQ;
            const int c = 256 * j + 4 * lane;
            f32x4 sm = {0.f, 0.f, 0.f, 0.f};
            for (int t = lo; t < hi; ++t) { const u32x2 a = *(const u32x2*)(Z + (size_t)(b * SEQ + t) * DM + c);
                sm.x += bf2f(a.x & 0xffff); sm.y += bf2f(a.x >> 16); sm.z += bf2f(a.y & 0xffff); sm.w += bf2f(a.y >> 16); }
            const u32x2 a = *(const u32x2*)(Z + (size_t)row * DM + c);
            const f32x4 zc = {bf2f(a.x & 0xffff), bf2f(a.x >> 16), bf2f(a.y & 0xffff), bf2f(a.y >> 16)};
            const float inv = 1.f / (float)(hi - lo);
            const f32x4 ps = *(const f32x4*)(P.pool_scale + c), gg = *(const f32x4*)(g1 + c);
            v[j] += gg * ps * (sm * inv - zc);
        }
#pragma unroll
        for (int j = 0; j < 4; ++j) *(f32x4*)(P.out + (size_t)row * DM + 256 * j + 4 * lane) = v[j];
        norm2_route(P, 1, row, lane, v);
    }
}
__device__ __forceinline__ void rows_final(const Ptrs& P, int gw, int NGW, int lane) {
    for (int row = gw; row < NTOK; row += NGW) {
        f32x4 v[4]; row_load(P.out + (size_t)row * DM, lane, v);
        moe_combine(P, 1, row, lane, v);
        const float rstd = row_rstd(v);
#pragma unroll
        for (int j = 0; j < 4; ++j) { const int c = 256 * j + 4 * lane; const f32x4 w = *(const f32x4*)(P.final_norm_w + c); *(f32x4*)(P.out + (size_t)row * DM + c) = v[j] * rstd * w; }
    }
}

constexpr int NPHASE = 15;
struct MArgs { Ptrs P; int ph_lo, ph_hi, bar_region, pad; };
__global__ void __launch_bounds__(512, 2) mega(MArgs a) {
    extern __shared__ __attribute__((aligned(16))) unsigned char lds_raw[];
    LAS unsigned char* lds = (LAS unsigned char*)lds_raw;
    const Ptrs& P = a.P;
    const int tid = threadIdx.x, lane = tid & 63, wave = __builtin_amdgcn_readfirstlane(tid >> 6);
    const int G = gridDim.x, bx = blockIdx.x;
    const int vcu = (G % 8 == 0) ? (bx % 8) * (G / 8) + bx / 8 : bx;
    volatile LAS unsigned* MISC = (volatile LAS unsigned*)(lds + LDS_MISC);
    for (int u = tid; u < (LDS_BYTES - LDS_MISC) / 4; u += 512) ((LAS unsigned*)(lds + LDS_MISC))[u] = 0u;
    __syncthreads();
    unsigned char* ws = P.ws;
    unsigned* ctl = (unsigned*)(ws + WS_CTL);
    const int lo = a.ph_lo, hi = a.ph_hi;
    XcdBarrier bar; bar.bar = ctl + CW_BAR + a.bar_region * XCD_BAR_WORDS; bar.x = 0; bar.st = nullptr;
    if (hi - lo > 1) bar = xcd_barrier_post(ctl + CW_BAR + a.bar_region * XCD_BAR_WORDS, MISC + 8);
    const int gw = vcu * 8 + wave, NGW = G * 8;
#define IN(k) (lo <= (k) && (k) < hi)
#define SEAM(k) do { if (IN(k) && IN((k) + 1)) xcd_barrier(bar); } while (0)
    if (IN(0)) {
        LAS float* scr = (LAS float*)(lds + wave * 16384);
        bf16_t* WIN = (bf16_t*)(ws + WS_WIN); bf16_t* WOUT = (bf16_t*)(ws + WS_WOUT); bf16_t* WPOOL = (bf16_t*)(ws + WS_WPOOL); bf16_t* WGU = (bf16_t*)(ws + WS_WGU); bf16_t* WD = (bf16_t*)(ws + WS_WD);
        constexpr int I_IN = 16 * 96, I_OUT = 16 * 32, I_POOL = 4 * 4 * 8, I_G = 32 * 16 * 16, I_U = I_G, I_D = 32 * 8 * 32;
        constexpr int NITEMS = I_IN + I_OUT + I_POOL + I_G + I_U + I_D;
        for (int it = gw; it < NITEMS; it += NGW) {
            int r = it;
            if (r < I_IN) { const int kb = r / 96, nb = r % 96; p0_transpose_item(P.w_in, INW, 64 * kb, 32 * nb, WIN, DM, 32 * nb, scr, lane); continue; } r -= I_IN;
            if (r < I_OUT) { const int kb = r / 32, nb = r % 32; p0_transpose_item(P.w_out, DM, 64 * kb, 32 * nb, WOUT, DM, 32 * nb, scr, lane); continue; } r -= I_OUT;
            if (r < I_POOL) { const int g = r / 32, q = r % 32, kb = q / 8, nb = q % 8; p0_transpose_item(P.pool_w + (size_t)g * 65536, 256, 64 * kb, 32 * nb, WPOOL + (size_t)g * 65536, 256, 32 * nb, scr, lane); continue; } r -= I_POOL;
            if (r < I_G + I_U) { const bool up = r >= I_G; if (up) r -= I_G; const int le = r / 256, q = r % 256, kb = q / 16, nb = q % 16, j0 = 32 * nb;
                const float* W = (up ? P.moe_w_up : P.moe_w_gate) + (size_t)le * DM * DE;
                p0_transpose_item(W, DE, 64 * kb, j0, WGU + (size_t)le * 1024 * 1024, DM, 256 * (j0 >> 7) + (j0 & 127) + (up ? 128 : 0), scr, lane); continue; } r -= I_G + I_U;
            { const int le = r / 256, q = r % 256, kb = q / 32, nb = q % 32; p0_transpose_item(P.moe_w_down + (size_t)le * DE * DM, DM, 64 * kb, 32 * nb, WD + (size_t)le * 1024 * 512, DE, 32 * nb, scr, lane); }
        }
        __syncthreads();
        for (int it = vcu; it < 192; it += G) {
            LAS float* sc = (LAS float*)lds;
            LAS float* red = (LAS float*)(lds + 40960);
            const int l = it / 96, n0 = (it % 96) * 64;
            for (int i = tid; i < 9 * 1024; i += 512) { const int r = i >> 10, k = i & 1023; const float v = r < 8 ? P.c[r * 1024 + k] : P.c_ctx[k]; sc[i] = silu_f(v); }
            __syncthreads();
            const int kq = tid >> 6, j = tid & 63;
            float acc[9];
#pragma unroll
            for (int r = 0; r < 9; ++r) acc[r] = 0.f;
            const float* W = P.ada_w + (size_t)l * 1024 * 6144 + n0 + j;
#pragma unroll 4
            for (int k = kq * 128; k < kq * 128 + 128; ++k) { const float w = W[(size_t)k * 6144];
#pragma unroll
                for (int r = 0; r < 9; ++r) acc[r] += sc[r * 1024 + k] * w; }
#pragma unroll
            for (int r = 0; r < 9; ++r) red[(kq * 9 + r) * 64 + j] = acc[r];
            __syncthreads();
            float* MOD = (float*)(ws + WS_MOD);
            for (int i = tid; i < 9 * 64; i += 512) { const int r = i >> 6, jj = i & 63; float sm = P.ada_b[l * 6144 + n0 + jj];
#pragma unroll
                for (int q = 0; q < 8; ++q) sm += red[(q * 9 + r) * 64 + jj];
                MOD[((size_t)l * 9 + r) * 6144 + n0 + jj] = sm; }
            __syncthreads();
        }
        if (vcu == G - 1) {
            float* par = (float*)(ws + WS_PAR);
            for (int i = tid; i < 64 * 16; i += 512) { const int pos = i >> 4, f = i & 15; const float inv = powf(10000.f, -(float)f / 16.f); const float ang = (float)pos * inv;
                par[2 * i] = cosf(ang); par[2 * i + 1] = sinf(ang); }
            if (tid < 64) { const float* lv = P.diff_lambda; float x = lv[tid] * lv[64 + tid], y = lv[128 + tid] * lv[192 + tid]; x = wave_sum(x); y = wave_sum(y);
                if (tid == 0) par[4096] = expf(x) - expf(y) + 0.2f; }
        }
    }
    SEAM(0);
    if (IN(1)) {
        for (int row = gw; row < NROW; row += NGW) {
            const float* src = row < NTOK ? P.x + (size_t)row * DM : P.ctx + (size_t)(row - NTOK) * DM;
            const int r = row < NTOK ? row / SEQ : 8;
            const float* MOD = (const float*)(ws + WS_MOD) + (size_t)r * 6144;
            f32x4 v[4]; row_load(src, lane, v);
            const float rstd = row_rstd(v);
            row_normmod(v, rstd, P.norm_mix_w, MOD + 0, MOD + 1024, lane);
            row_store_bf16((bf16_t*)(ws + WS_RA) + (size_t)row * DM, lane, v);
        }
    }
    SEAM(1);
    if (IN(2)) {
        ProjOrder S{G, bx, (const bf16_t*)(ws + WS_WIN)};
        EpiProj E{(bf16_t*)(ws + WS_RB), (const float*)(ws + WS_PAR)};
        pg8::gemm_phase<EpiProj, ProjOrder>(lds, (const bf16_t*)(ws + WS_RA), DM, DM, S, E);
    }
    SEAM(2);
    if (IN(3)) {
        const float lam = ((const float*)(ws + WS_PAR))[4096];
        for (int U = vcu; U < 512; U += G) { const int bh = U >> 4, qb = U & 15; att::attn_unit(lds, (const bf16_t*)(ws + WS_RB), (bf16_t*)(ws + WS_RA), P.diff_subln_w, lam, bh >> 2, bh & 3, qb); }
        for (int U = vcu; U < 576; U += G) { const int bh = U / 18, x = U % 18; ret::summary_unit(lds, (const bf16_t*)(ws + WS_RB), (float*)(ws + WS_KVS), P.ret_log_decay, bh >> 2, bh & 3, x); }
    }
    SEAM(3);
    if (IN(4)) {
        for (int U = vcu; U < 512; U += G) { const int bh = U >> 4, ci = U & 15; ret::output_unit(lds, (const bf16_t*)(ws + WS_RB), (const float*)(ws + WS_KVS), (bf16_t*)(ws + WS_RA), P.ret_log_decay, bh >> 2, bh & 3, ci); }
    }
    SEAM(4);
    if (IN(5)) {
        OutOrder S{G, bx, (const bf16_t*)(ws + WS_WOUT)};
        EpiOut E{P.x, P.out, (const float*)(ws + WS_MOD) + 2048};
        pg8::gemm_phase<EpiOut, OutOrder>(lds, (const bf16_t*)(ws + WS_RA), DM, DM, S, E);
    }
    SEAM(5);
    if (IN(6)) rows_norm2_route0(P, gw, NGW, lane);
    SEAM(6);
    if (IN(7)) moe_gateup_phase<0>(lds, MISC, ws, G, vcu);
    SEAM(7);
    if (IN(8)) moe_down_phase<0>(lds, MISC, ws, G, vcu);
    SEAM(8);
    if (IN(9)) rows_combine_norm1(P, gw, NGW, lane);
    SEAM(9);
    if (IN(10)) {
        PoolOrder S{G, bx, (const bf16_t*)(ws + WS_WPOOL)};
        EpiPool E{(bf16_t*)(ws + WS_Y)};
        pg8::gemm_phase<EpiPool, PoolOrder>(lds, (const bf16_t*)(ws + WS_RA), 256, 256, S, E);
    }
    SEAM(10);
    if (IN(11)) rows_pool_norm2_route1(P, gw, NGW, lane);
    SEAM(11);
    if (IN(12)) moe_gateup_phase<1>(lds, MISC, ws, G, vcu);
    SEAM(12);
    if (IN(13)) moe_down_phase<1>(lds, MISC, ws, G, vcu);
    SEAM(13);
    if (IN(14)) rows_final(P, gw, NGW, lane);
#undef IN
#undef SEAM
}

static void launch_mega(const Ptrs& P, int lo, int hi, hipStream_t stream) { MArgs a{}; a.P = P; a.ph_lo = lo; a.ph_hi = hi; a.bar_region = 0; hipLaunchKernelGGL(mega, dim3(256), dim3(512), LDS_BYTES, stream, a); }
extern "C" void kernel_launch(void* const* d_in, const int* in_sizes, int n_in, void* d_out, int out_size, void* d_ws, size_t ws_size, hipStream_t stream) {
    if (n_in != 21 || out_size != NTOK * DM || ws_size < WS_NEED) { fprintf(stderr, "kernel_launch: bad shapes n_in %d out %d ws %zu (need %zu)\n", n_in, out_size, ws_size, (size_t)WS_NEED); return; }
    static int inited = 0;
    if (!inited) { if (hipFuncSetAttribute((const void*)mega, hipFuncAttributeMaxDynamicSharedMemorySize, LDS_BYTES) != hipSuccess) { fprintf(stderr, "hipFuncSetAttribute failed\n"); return; } inited = 1; }
    Ptrs P{};
    const float** pp = (const float**)&P;
    for (int i = 0; i < 21; ++i) pp[i] = (const float*)d_in[i];
    P.out = (float*)d_out; P.ws = (unsigned char*)d_ws;
    (void)hipMemsetAsync(P.ws + WS_CTL, 0, 1 * MiB, stream);
#ifndef MK_LAUNCHES
#define MK_LAUNCHES 1
#endif
    if (MK_LAUNCHES == 1) launch_mega(P, 0, NPHASE, stream);
    else for (int ph = 0; ph < NPHASE; ++ph) launch_mega(P, ph, ph + 1, stream);
}
```

```cpp
#include <hip/hip_runtime.h>
#include <stdint.h>
#include <cstdio>

typedef unsigned short bf16_t;
typedef short bf16x8 __attribute__((ext_vector_type(8)));
typedef float f32x4 __attribute__((ext_vector_type(4)));
typedef unsigned u32x4 __attribute__((ext_vector_type(4)));
typedef unsigned u32x2 __attribute__((ext_vector_type(2)));

constexpr int DM = 1024, NB = 8, SEQ = 2048, NTOK = NB * SEQ, CTXL = 256, NCTX = NB * CTXL, NROW = NTOK + NCTX;
constexpr int INW = 3072;
constexpr int C_RQ = 0, C_DQ = 256, C_RG = 768, C_RK = 1280, C_RV = 1536, C_DK = 2048, C_DV = 2560;
constexpr int NE = 16, DE = 512;
constexpr float EPS = 1e-6f;
constexpr float LOG2E = 1.4426950408889634f;
constexpr int ECAP = 16384;
constexpr int HROWS = 37120;

constexpr size_t MiB = 1u << 20;
constexpr size_t WS_CTL = 0;
constexpr size_t WS_MOD = 1 * MiB;
constexpr size_t WS_PAR = 2 * MiB;
constexpr size_t WS_ROUTE = 3 * MiB;
constexpr size_t WS_RA = 160 * MiB;
constexpr size_t WS_RB = 200 * MiB;
constexpr size_t WS_HID = WS_RB;
constexpr size_t WS_Y = WS_RB + (size_t)HROWS * DE * 2;
constexpr size_t WS_END = WS_RB + (size_t)NROW * INW * 2;
static_assert(WS_Y + (size_t)HROWS * DM * 2 <= WS_END + 2 * MiB, "HID+Y fit the PROJ region (+slack)");
constexpr size_t WS_NEED = WS_END + 2 * MiB;

constexpr int CW_CNT = 1024;

__device__ __forceinline__ unsigned f2bf(float f) { unsigned u = __float_as_uint(f); return (u + 0x7fffu + ((u >> 16) & 1u)) >> 16; }
__device__ __forceinline__ float bf2f(unsigned b) { return __uint_as_float(b << 16); }
__device__ __forceinline__ unsigned pk2(float lo, float hi) { return f2bf(lo) | (f2bf(hi) << 16); }
__device__ __forceinline__ float wave_sum(float v) {
#pragma unroll
    for (int o = 1; o < 64; o <<= 1) v += __shfl_xor(v, o);
    return v;
}
__device__ __forceinline__ float wave_max(float v) {
#pragma unroll
    for (int o = 1; o < 64; o <<= 1) v = fmaxf(v, __shfl_xor(v, o));
    return v;
}
__device__ __forceinline__ float silu_f(float x) { return x / (1.f + __expf(-x)); }

struct Ptrs {
    const float *x, *c, *ctx, *c_ctx, *ada_w, *ada_b, *norm_mix_w, *norm_ffn_w, *w_in, *w_out, *ret_log_decay, *diff_lambda, *diff_subln_w,
        *pool_w, *pool_scale, *router_w, *router_b, *moe_w_gate, *moe_w_up, *moe_w_down, *final_norm_w;
    float* out; unsigned char* ws;
};

__global__ void __launch_bounds__(256) k_mod(Ptrs P) {
    __shared__ float sc[9][1024];
    __shared__ float red[4][9][64];
    const int tid = threadIdx.x, l = blockIdx.y, n0 = blockIdx.x * 64;
    for (int i = tid; i < 9 * 1024; i += 256) { const int r = i >> 10, k = i & 1023; const float v = r < 8 ? P.c[r * 1024 + k] : P.c_ctx[k]; sc[r][k] = silu_f(v); }
    __syncthreads();
    const int kq = tid >> 6, j = tid & 63;
    float acc[9];
#pragma unroll
    for (int r = 0; r < 9; ++r) acc[r] = 0.f;
    const float* W = P.ada_w + (size_t)l * 1024 * 6144 + n0 + j;
    for (int k = kq * 256; k < kq * 256 + 256; ++k) {
        const float w = W[(size_t)k * 6144];
#pragma unroll
        for (int r = 0; r < 9; ++r) acc[r] += sc[r][k] * w;
    }
#pragma unroll
    for (int r = 0; r < 9; ++r) red[kq][r][j] = acc[r];
    __syncthreads();
    float* MOD = (float*)(P.ws + WS_MOD);
    for (int i = tid; i < 9 * 64; i += 256) { const int r = i >> 6, jj = i & 63;
        MOD[((size_t)l * 9 + r) * 6144 + n0 + jj] = red[0][r][jj] + red[1][r][jj] + red[2][r][jj] + red[3][r][jj] + P.ada_b[l * 6144 + n0 + jj]; }
    if (blockIdx.x == 0 && blockIdx.y == 0) {
        float* par = (float*)(P.ws + WS_PAR);
        for (int i = tid; i < 64 * 16; i += 256) { const int pos = i >> 4, f = i & 15; const float inv = powf(10000.f, -(float)f / 16.f); const float ang = (float)pos * inv;
            par[2 * i] = cosf(ang); par[2 * i + 1] = sinf(ang); }
        if (tid < 64) {
            const float* lv = P.diff_lambda;
            float a = lv[tid] * lv[64 + tid], b = lv[128 + tid] * lv[192 + tid];
            a = wave_sum(a); b = wave_sum(b);
            if (tid == 0) par[4096] = expf(a) - expf(b) + 0.2f;
        }
    }
}

__device__ __forceinline__ void row_load(const float* p, int lane, f32x4 (&v)[4]) {
#pragma unroll
    for (int j = 0; j < 4; ++j) v[j] = *(const f32x4*)(p + 256 * j + 4 * lane);
}
__device__ __forceinline__ float row_rstd(const f32x4 (&v)[4]) {
    float s = 0.f;
#pragma unroll
    for (int j = 0; j < 4; ++j) s += (v[j].x * v[j].x + v[j].y * v[j].y) + (v[j].z * v[j].z + v[j].w * v[j].w);
    return rsqrtf(wave_sum(s) * (1.f / 1024.f) + EPS);
}
__device__ __forceinline__ void row_normmod(f32x4 (&v)[4], float rstd, const float* nw, const float* sh, const float* sc, int lane) {
#pragma unroll
    for (int j = 0; j < 4; ++j) { const int c = 256 * j + 4 * lane; const f32x4 w = *(const f32x4*)(nw + c), s = *(const f32x4*)(sc + c), h = *(const f32x4*)(sh + c);
        v[j] = (v[j] * rstd * w) * (s + 1.f) + h; }
}
__device__ __forceinline__ void row_store_bf16(bf16_t* p, int lane, const f32x4 (&v)[4]) {
#pragma unroll
    for (int j = 0; j < 4; ++j) { u32x2 w; w.x = pk2(v[j].x, v[j].y); w.y = pk2(v[j].z, v[j].w); *(u32x2*)(p + 256 * j + 4 * lane) = w; }
}

__global__ void __launch_bounds__(256) k_norm_in(Ptrs P) {
    const int lane = threadIdx.x & 63, row = blockIdx.x * 4 + (threadIdx.x >> 6);
    if (row >= NROW) return;
    const float* src = row < NTOK ? P.x + (size_t)row * DM : P.ctx + (size_t)(row - NTOK) * DM;
    const int r = row < NTOK ? row / SEQ : 8;
    const float* MOD = (const float*)(P.ws + WS_MOD) + (size_t)(0 * 9 + r) * 6144;
    f32x4 v[4]; row_load(src, lane, v);
    const float rstd = row_rstd(v);
    row_normmod(v, rstd, P.norm_mix_w, MOD + 0, MOD + 1024, lane);
    row_store_bf16((bf16_t*)(P.ws + WS_RA) + (size_t)row * DM, lane, v);
}

enum { EPI_BF16 = 0, EPI_RESID = 1, EPI_F32 = 2, EPI_GATEUP = 3 };
struct GemmP {
    const bf16_t* A;
    const float* W;
    const unsigned* cnt;
    const int* tok_of;
    const float* w_of;
    void* O;
    const float* aux;
    const float* gvec;
    float* Oresid;
    size_t w_estride;
    int lda, ldw, M, N, K, grouped, ldo, ldaux;
};
template <int EPI>
__global__ void __launch_bounds__(256) k_gemm(GemmP g) {
    __shared__ __attribute__((aligned(16))) bf16_t sA[128][40];
    __shared__ __attribute__((aligned(16))) bf16_t sB[128][40];
    const int tid = threadIdx.x, lane = tid & 63, wid = tid >> 6, wr = wid >> 1, wc = wid & 1, fr = lane & 15, fq = lane >> 4;
    const int m0 = blockIdx.y * 128, n0 = blockIdx.x * 128;
    int Mloc = g.M, rowbase = 0; const float* W = g.W; const int* toks = nullptr; const float* wts = nullptr;
    if (g.grouped) {
        const int e = blockIdx.z; int base = 0, ce = 0;
        for (int i = 0; i < NE; ++i) { const int c = (int)g.cnt[i * 64]; if (i == e) { rowbase = base; ce = c; } base += (c + 255) / 256 * 256; }
        Mloc = ce; if (m0 >= Mloc) return;
        W += (size_t)e * g.w_estride;
        if (g.tok_of) toks = g.tok_of + (size_t)e * ECAP;
        if (g.w_of) wts = g.w_of + (size_t)e * ECAP;
    }
    const int ar = tid >> 1, ac = (tid & 1) * 16;
    int arow = m0 + ar; if (arow >= Mloc) arow = Mloc - 1;
    size_t asrc_row;
    if (g.grouped) asrc_row = toks ? (size_t)toks[arow] : (size_t)(rowbase + arow); else asrc_row = (size_t)arow;
    const bf16_t* Ap = g.A + asrc_row * g.lda + ac;
    const int bk = (tid >> 5) * 4, bn = (tid & 31) * 4;
    f32x4 acc[4][4];
#pragma unroll
    for (int i = 0; i < 4; ++i)
#pragma unroll
        for (int j = 0; j < 4; ++j) acc[i][j] = (f32x4){0.f, 0.f, 0.f, 0.f};
    for (int k0 = 0; k0 < g.K; k0 += 32) {
        const u32x4 a0 = *(const u32x4*)(Ap + k0), a1 = *(const u32x4*)(Ap + k0 + 8);
        f32x4 b[4];
#pragma unroll
        for (int i = 0; i < 4; ++i) b[i] = *(const f32x4*)(W + (size_t)(k0 + bk + i) * g.ldw + n0 + bn);
        __syncthreads();
        *(u32x4*)&sA[ar][ac] = a0; *(u32x4*)&sA[ar][ac + 8] = a1;
#pragma unroll
        for (int j = 0; j < 4; ++j) { u32x2 w; w.x = pk2(b[0][j], b[1][j]); w.y = pk2(b[2][j], b[3][j]); *(u32x2*)&sB[bn + j][bk] = w; }
        __syncthreads();
        bf16x8 af[4], bfr[4];
#pragma unroll
        for (int i = 0; i < 4; ++i) af[i] = *(const bf16x8*)&sA[wr * 64 + i * 16 + fr][fq * 8];
#pragma unroll
        for (int j = 0; j < 4; ++j) bfr[j] = *(const bf16x8*)&sB[wc * 64 + j * 16 + fr][fq * 8];
#pragma unroll
        for (int i = 0; i < 4; ++i)
#pragma unroll
            for (int j = 0; j < 4; ++j) acc[i][j] = __builtin_amdgcn_mfma_f32_16x16x32_bf16(af[i], bfr[j], acc[i][j], 0, 0, 0);
    }
#pragma unroll
    for (int i = 0; i < 4; ++i)
#pragma unroll
        for (int r = 0; r < 4; ++r) {
            const int m = m0 + wr * 64 + i * 16 + fq * 4 + r;
            if (m >= Mloc) continue;
            const size_t orow = g.grouped ? (size_t)(rowbase + m) : (size_t)m;
#pragma unroll
            for (int j = 0; j < 4; ++j) {
                const int n = n0 + wc * 64 + j * 16 + fr; const float v = acc[i][j][r];
                if (EPI == EPI_BF16) ((bf16_t*)g.O)[orow * g.ldo + n] = (bf16_t)f2bf(v);
                else if (EPI == EPI_F32) ((float*)g.O)[orow * g.ldo + n] = v;
                else if (EPI == EPI_RESID) { const int b = m / SEQ; g.Oresid[orow * DM + n] = g.aux[orow * g.ldaux + n] + g.gvec[(size_t)b * 6144 + n] * v; }
                else if (EPI == EPI_GATEUP) { const float gt = g.aux[orow * g.ldaux + n]; ((bf16_t*)g.O)[orow * g.ldo + n] = (bf16_t)f2bf(silu_f(gt) * v * wts[m]); }
            }
        }
}

__global__ void __launch_bounds__(256) k_rope(Ptrs P) {
    bf16_t* PROJ = (bf16_t*)(P.ws + WS_RB);
    const float* tab = (const float*)(P.ws + WS_PAR);
    const int row = blockIdx.x;
    const int tid = threadIdx.x;
    if (row >= NTOK) {
        bf16_t* p = PROJ + (size_t)row * INW + C_RK; p[tid] = (bf16_t)f2bf(bf2f(p[tid]) * 0.125f); return;
    }
    const int t = row % SEQ, prow = t >> 6, pcol = t & 63;
    for (int it = tid; it < 768; it += 256) {
        const int hv = it >> 5, pi = it & 31, half = pi >> 4, f = pi & 15;
        int cb; float scale;
        if (hv < 4) { cb = C_RQ + hv * 64; scale = 1.f; }
        else if (hv < 12) { cb = C_DQ + (hv - 4) * 64; scale = 0.125f * LOG2E; }
        else if (hv < 16) { cb = C_RK + (hv - 12) * 64; scale = 0.125f; }
        else { cb = C_DK + (hv - 16) * 64; scale = 1.f; }
        const int pos = half ? pcol : prow;
        const float cs = tab[2 * (pos * 16 + f)], sn = tab[2 * (pos * 16 + f) + 1];
        bf16_t* p = PROJ + (size_t)row * INW + cb + half * 32 + f;
        const float x1 = bf2f(p[0]), x2 = bf2f(p[16]);
        p[0] = (bf16_t)f2bf((x1 * cs - x2 * sn) * scale); p[16] = (bf16_t)f2bf((x1 * sn + x2 * cs) * scale);
    }
}

__global__ void __launch_bounds__(256) k_attn_naive(Ptrs P) {
    __shared__ float pbuf[4][2304];
    const bf16_t* PROJ = (const bf16_t*)(P.ws + WS_RB);
    bf16_t* MIX = (bf16_t*)(P.ws + WS_RA);
    const float lam = ((const float*)(P.ws + WS_PAR))[4096];
    const int lane = threadIdx.x & 63, w = threadIdx.x >> 6, row = blockIdx.x * 4 + w, h = blockIdx.y, b = row / SEQ;
    float* pb = pbuf[w];
    for (int c = 0; c < 2; ++c) {
        float q[64];
        const bf16_t* qp = PROJ + (size_t)row * INW + C_DQ + h * 128 + c * 64;
#pragma unroll
        for (int d = 0; d < 64; d += 8) { const u32x4 u = *(const u32x4*)(qp + d);
            q[d] = bf2f(u.x & 0xffff); q[d + 1] = bf2f(u.x >> 16); q[d + 2] = bf2f(u.y & 0xffff); q[d + 3] = bf2f(u.y >> 16);
            q[d + 4] = bf2f(u.z & 0xffff); q[d + 5] = bf2f(u.z >> 16); q[d + 6] = bf2f(u.w & 0xffff); q[d + 7] = bf2f(u.w >> 16); }
        float s[36]; float mx = -1e30f;
#pragma unroll
        for (int i = 0; i < 36; ++i) {
            const int kk = lane + 64 * i;
            const size_t krow = kk < CTXL ? (size_t)(NTOK + b * CTXL + kk) : (size_t)(b * SEQ + kk - CTXL);
            const bf16_t* kp = PROJ + krow * INW + C_DK + h * 128 + c * 64;
            float a = 0.f;
#pragma unroll
            for (int d = 0; d < 64; d += 8) { const u32x4 u = *(const u32x4*)(kp + d);
                a += q[d] * bf2f(u.x & 0xffff) + q[d + 1] * bf2f(u.x >> 16) + q[d + 2] * bf2f(u.y & 0xffff) + q[d + 3] * bf2f(u.y >> 16)
                   + q[d + 4] * bf2f(u.z & 0xffff) + q[d + 5] * bf2f(u.z >> 16) + q[d + 6] * bf2f(u.w & 0xffff) + q[d + 7] * bf2f(u.w >> 16); }
            s[i] = a; mx = fmaxf(mx, a);
        }
        mx = wave_max(mx);
        float l = 0.f;
#pragma unroll
        for (int i = 0; i < 36; ++i) { s[i] = exp2f(s[i] - mx); l += s[i]; }
        l = wave_sum(l);
        const float f = (c == 0 ? 1.f : -lam) / l;
#pragma unroll
        for (int i = 0; i < 36; ++i) { const int kk = lane + 64 * i; if (c == 0) pb[kk] = s[i] * f; else pb[kk] += s[i] * f; }
    }
    __builtin_amdgcn_s_waitcnt(0);
    float o0 = 0.f, o1 = 0.f;
    for (int kk = 0; kk < 2304; ++kk) {
        const size_t krow = kk < CTXL ? (size_t)(NTOK + b * CTXL + kk) : (size_t)(b * SEQ + kk - CTXL);
        const bf16_t* vp = PROJ + krow * INW + C_DV + h * 128;
        const float p = pb[kk];
        o0 += p * bf2f(vp[lane]); o1 += p * bf2f(vp[64 + lane]);
    }
    const float ss = wave_sum(o0 * o0 + o1 * o1);
    const float r = rsqrtf(ss * (1.f / 128.f) + EPS) * 0.8f;
    bf16_t* mp = MIX + (size_t)row * DM + 512 + h * 128;
    mp[lane] = (bf16_t)f2bf(o0 * r * P.diff_subln_w[lane]); mp[64 + lane] = (bf16_t)f2bf(o1 * r * P.diff_subln_w[64 + lane]);
}

__global__ void __launch_bounds__(256) k_ret_naive(Ptrs P) {
    __shared__ float pbuf[4][2304];
    const bf16_t* PROJ = (const bf16_t*)(P.ws + WS_RB);
    bf16_t* MIX = (bf16_t*)(P.ws + WS_RA);
    const int lane = threadIdx.x & 63, w = threadIdx.x >> 6, row = blockIdx.x * 4 + w, h = blockIdx.y, b = row / SEQ, n = row % SEQ;
    const float ld0 = P.ret_log_decay[h], ld1 = P.ret_log_decay[4 + h];
    float* pb = pbuf[w];
    float q[64];
    const bf16_t* qp = PROJ + (size_t)row * INW + C_RQ + h * 64;
#pragma unroll
    for (int d = 0; d < 64; d += 8) { const u32x4 u = *(const u32x4*)(qp + d);
        q[d] = bf2f(u.x & 0xffff); q[d + 1] = bf2f(u.x >> 16); q[d + 2] = bf2f(u.y & 0xffff); q[d + 3] = bf2f(u.y >> 16);
        q[d + 4] = bf2f(u.z & 0xffff); q[d + 5] = bf2f(u.z >> 16); q[d + 6] = bf2f(u.w & 0xffff); q[d + 7] = bf2f(u.w >> 16); }
    for (int i = 0; i < 36; ++i) {
        const int kk = lane + 64 * i;
        size_t krow; float wgt;
        if (kk < CTXL) { krow = (size_t)(NTOK + b * CTXL + kk); wgt = __expf(ld0 * (float)(n + 256 - kk)) + __expf(ld1 * (float)(SEQ - n + kk)); }
        else { const int m = kk - CTXL; krow = (size_t)(b * SEQ + m); const int d = n - m; wgt = d > 0 ? __expf(ld0 * (float)d) : (d < 0 ? __expf(ld1 * (float)(-d)) : 2.f); }
        const bf16_t* kp = PROJ + krow * INW + C_RK + h * 64;
        float a = 0.f;
#pragma unroll
        for (int d = 0; d < 64; d += 8) { const u32x4 u = *(const u32x4*)(kp + d);
            a += q[d] * bf2f(u.x & 0xffff) + q[d + 1] * bf2f(u.x >> 16) + q[d + 2] * bf2f(u.y & 0xffff) + q[d + 3] * bf2f(u.y >> 16)
               + q[d + 4] * bf2f(u.z & 0xffff) + q[d + 5] * bf2f(u.z >> 16) + q[d + 6] * bf2f(u.w & 0xffff) + q[d + 7] * bf2f(u.w >> 16); }
        pb[kk] = a * wgt;
    }
    __builtin_amdgcn_s_waitcnt(0);
    float o0 = 0.f, o1 = 0.f;
    for (int kk = 0; kk < 2304; ++kk) {
        const size_t krow = kk < CTXL ? (size_t)(NTOK + b * CTXL + kk) : (size_t)(b * SEQ + kk - CTXL);
        const bf16_t* vp = PROJ + krow * INW + C_RV + h * 128;
        const float p = pb[kk];
        o0 += p * bf2f(vp[lane]); o1 += p * bf2f(vp[64 + lane]);
    }
    const float ss = wave_sum(o0 * o0 + o1 * o1);
    const float r = rsqrtf(ss * (1.f / 128.f) + EPS);
    const bf16_t* gp = PROJ + (size_t)row * INW + C_RG + h * 128;
    bf16_t* mp = MIX + (size_t)row * DM + h * 128;
    mp[lane] = (bf16_t)f2bf(o0 * r * silu_f(bf2f(gp[lane]))); mp[64 + lane] = (bf16_t)f2bf(o1 * r * silu_f(bf2f(gp[64 + lane])));
}

__device__ __forceinline__ void norm2_route(const Ptrs& P, int layer, int row, int lane, f32x4 (&v)[4]) {
    const int b = row / SEQ;
    const float* MOD = (const float*)(P.ws + WS_MOD) + (size_t)(layer * 9 + b) * 6144;
    const float rstd = row_rstd(v);
    row_normmod(v, rstd, P.norm_ffn_w + layer * DM, MOD + 3072, MOD + 4096, lane);
    row_store_bf16((bf16_t*)(P.ws + WS_RA) + (size_t)row * DM, lane, v);
    float lg[16];
#pragma unroll
    for (int e = 0; e < 16; ++e) lg[e] = 0.f;
#pragma unroll
    for (int j = 0; j < 4; ++j)
#pragma unroll
        for (int i = 0; i < 4; ++i) {
            const float hv = v[j][i]; const float* rw = P.router_w + (size_t)(256 * j + 4 * lane + i) * 16;
#pragma unroll
            for (int e4 = 0; e4 < 4; ++e4) { const f32x4 w = *(const f32x4*)(rw + 4 * e4); lg[4 * e4] += hv * w.x; lg[4 * e4 + 1] += hv * w.y; lg[4 * e4 + 2] += hv * w.z; lg[4 * e4 + 3] += hv * w.w; }
        }
#pragma unroll
    for (int e = 0; e < 16; ++e) lg[e] = wave_sum(lg[e]);
    if (lane == 0) {
        float s[16], bz[16];
#pragma unroll
        for (int e = 0; e < 16; ++e) { s[e] = 1.f / (1.f + expf(-lg[e])); bz[e] = s[e] + P.router_b[e]; }
        int gsel = 0; float gbest = -1e30f;
#pragma unroll
        for (int gi = 0; gi < 4; ++gi) {
            float m1 = -1e30f, m2 = -1e30f;
#pragma unroll
            for (int k = 0; k < 4; ++k) { const float t = bz[gi * 4 + k]; if (t > m1) { m2 = m1; m1 = t; } else if (t > m2) m2 = t; }
            const float gs = m1 + m2; if (gs > gbest) { gbest = gs; gsel = gi; }
        }
        int i1 = 0, i2 = 0; float m1 = -1e30f, m2 = -1e30f;
#pragma unroll
        for (int gi = 0; gi < 4; ++gi)
#pragma unroll
            for (int k = 0; k < 4; ++k) if (gi == gsel) { const float t = bz[gi * 4 + k]; const int id = gi * 4 + k;
                if (t > m1) { m2 = m1; i2 = i1; m1 = t; i1 = id; } else if (t > m2) { m2 = t; i2 = id; } }
        float s1 = 0.f, s2 = 0.f;
#pragma unroll
        for (int e = 0; e < 16; ++e) { if (e == i1) s1 = s[e]; if (e == i2) s2 = s[e]; }
        const float inv = 1.f / (s1 + s2);
        unsigned* cnt = (unsigned*)(P.ws + WS_CTL) + CW_CNT + layer * 16 * 64;
        int* tok_e = (int*)(P.ws + WS_ROUTE); int* tok_pos = tok_e + 4 * NTOK;
        int* tok_of = tok_e + 6 * NTOK; float* w_of = (float*)(tok_of + 16 * ECAP);
        const int p1 = (int)atomicAdd(&cnt[i1 * 64], 1u), p2 = (int)atomicAdd(&cnt[i2 * 64], 1u);
        tok_e[2 * row] = i1; tok_e[2 * row + 1] = i2; tok_pos[2 * row] = p1; tok_pos[2 * row + 1] = p2;
        tok_of[i1 * ECAP + p1] = row; tok_of[i2 * ECAP + p2] = row; w_of[i1 * ECAP + p1] = s1 * inv; w_of[i2 * ECAP + p2] = s2 * inv;
    }
}
__global__ void __launch_bounds__(256) k_norm2_route(Ptrs P, int layer) {
    const int lane = threadIdx.x & 63, row = blockIdx.x * 4 + (threadIdx.x >> 6);
    f32x4 v[4]; row_load(P.out + (size_t)row * DM, lane, v);
    norm2_route(P, layer, row, lane, v);
}

__device__ __forceinline__ void moe_combine(const Ptrs& P, int layer, int row, int lane, f32x4 (&v)[4]) {
    const unsigned* cnt = (const unsigned*)(P.ws + WS_CTL) + CW_CNT + layer * 16 * 64;
    const int* tok_e = (const int*)(P.ws + WS_ROUTE); const int* tok_pos = tok_e + 4 * NTOK;
    const int e0 = tok_e[2 * row], e1 = tok_e[2 * row + 1];
    int base = 0, rb0 = 0, rb1 = 0;
    for (int i = 0; i < NE; ++i) { if (i == e0) rb0 = base; if (i == e1) rb1 = base; base += ((int)cnt[i * 64] + 255) / 256 * 256; }
    const bf16_t* Y = (const bf16_t*)(P.ws + WS_Y);
    const bf16_t* y0 = Y + (size_t)(rb0 + tok_pos[2 * row]) * DM; const bf16_t* y1 = Y + (size_t)(rb1 + tok_pos[2 * row + 1]) * DM;
    const float* g2 = (const float*)(P.ws + WS_MOD) + (size_t)(layer * 9 + row / SEQ) * 6144 + 5120;
#pragma unroll
    for (int j = 0; j < 4; ++j) { const int c = 256 * j + 4 * lane; const u32x2 a = *(const u32x2*)(y0 + c), bb = *(const u32x2*)(y1 + c); const f32x4 gg = *(const f32x4*)(g2 + c);
        v[j].x += gg.x * (bf2f(a.x & 0xffff) + bf2f(bb.x & 0xffff)); v[j].y += gg.y * (bf2f(a.x >> 16) + bf2f(bb.x >> 16));
        v[j].z += gg.z * (bf2f(a.y & 0xffff) + bf2f(bb.y & 0xffff)); v[j].w += gg.w * (bf2f(a.y >> 16) + bf2f(bb.y >> 16)); }
}
__global__ void __launch_bounds__(256) k_combine_norm1(Ptrs P) {
    const int lane = threadIdx.x & 63, row = blockIdx.x * 4 + (threadIdx.x >> 6);
    f32x4 v[4]; row_load(P.out + (size_t)row * DM, lane, v);
    moe_combine(P, 0, row, lane, v);
#pragma unroll
    for (int j = 0; j < 4; ++j) *(f32x4*)(P.out + (size_t)row * DM + 256 * j + 4 * lane) = v[j];
    const float* MOD = (const float*)(P.ws + WS_MOD) + (size_t)(1 * 9 + row / SEQ) * 6144;
    const float rstd = row_rstd(v);
    row_normmod(v, rstd, P.norm_mix_w + DM, MOD + 0, MOD + 1024, lane);
    row_store_bf16((bf16_t*)(P.ws + WS_RA) + (size_t)row * DM, lane, v);
}
__global__ void __launch_bounds__(256) k_pool_norm2_route(Ptrs P) {
    const int lane = threadIdx.x & 63, row = blockIdx.x * 4 + (threadIdx.x >> 6);
    const int b = row / SEQ, pos = row % SEQ;
    const bf16_t* Z = (const bf16_t*)(P.ws + WS_Y);
    f32x4 v[4]; row_load(P.out + (size_t)row * DM, lane, v);
    const float* g1 = (const float*)(P.ws + WS_MOD) + (size_t)(1 * 9 + b) * 6144 + 2048;
#pragma unroll
    for (int j = 0; j < 4; ++j) {
        const int w = 2 << j, left = w / 2, right = w - 1 - left;
        int lo = pos - left; if (lo < 0) lo = 0; int hi = pos + right + 1; if (hi > SEQ) hi = SEQ;
        const int c = 256 * j + 4 * lane;
        f32x4 s = {0.f, 0.f, 0.f, 0.f};
        for (int t = lo; t < hi; ++t) { const u32x2 a = *(const u32x2*)(Z + (size_t)(b * SEQ + t) * DM + c);
            s.x += bf2f(a.x & 0xffff); s.y += bf2f(a.x >> 16); s.z += bf2f(a.y & 0xffff); s.w += bf2f(a.y >> 16); }
        const u32x2 a = *(const u32x2*)(Z + (size_t)row * DM + c);
        const f32x4 zc = {bf2f(a.x & 0xffff), bf2f(a.x >> 16), bf2f(a.y & 0xffff), bf2f(a.y >> 16)};
        const float inv = 1.f / (float)(hi - lo);
        const f32x4 ps = *(const f32x4*)(P.pool_scale + c), gg = *(const f32x4*)(g1 + c);
        v[j] += gg * ps * (s * inv - zc);
    }
#pragma unroll
    for (int j = 0; j < 4; ++j) *(f32x4*)(P.out + (size_t)row * DM + 256 * j + 4 * lane) = v[j];
    norm2_route(P, 1, row, lane, v);
}
__global__ void __launch_bounds__(256) k_final(Ptrs P) {
    const int lane = threadIdx.x & 63, row = blockIdx.x * 4 + (threadIdx.x >> 6);
    f32x4 v[4]; row_load(P.out + (size_t)row * DM, lane, v);
    moe_combine(P, 1, row, lane, v);
    const float rstd = row_rstd(v);
#pragma unroll
    for (int j = 0; j < 4; ++j) { const int c = 256 * j + 4 * lane; const f32x4 w = *(const f32x4*)(P.final_norm_w + c); *(f32x4*)(P.out + (size_t)row * DM + c) = v[j] * rstd * w; }
}


#define LAS __attribute__((address_space(3)))
#define GAS __attribute__((address_space(1)))
constexpr size_t WS_KVS = 8 * MiB;
constexpr size_t WS_WIN = 48 * MiB;
constexpr size_t WS_WOUT = 54 * MiB;
constexpr size_t WS_WPOOL = 56 * MiB;
constexpr size_t WS_WGU = 58 * MiB;
constexpr size_t WS_WD = 122 * MiB;
static_assert(WS_WD + (size_t)2 * 16 * 1024 * 512 * 2 <= WS_RA, "weights below RA");
constexpr int LDS_STAGE = 131072, LDS_MISC = LDS_STAGE, LDS_BYTES = 147456;

namespace pg8 {
constexpr int BM = 256, BK = 64, HALF = 128, HTB = HALF * BK * 2, STAGE_BYTES = 8 * HTB, NXCD = 8, WGM = 8;
__host__ __device__ __forceinline__ int lds_byte(int r, int c) { const int st = (r >> 4) * 2 + (c >> 5), rr = r & 15, cc = c & 31, ob = rr * 64 + cc * 2; return st * 1024 + (ob ^ (((ob >> 9) & 1) << 5)); }
__host__ __device__ __forceinline__ void stage_rc(int b, int& R, int& C) { const int st = b / 1024, sb = b % 1024, swz = sb ^ (((sb >> 9) & 1) << 5); R = (st >> 1) * 16 + swz / 64; C = (st & 1) * 32 + (swz % 64) / 2; }
__host__ __device__ __forceinline__ int perm32(int rho) { const int n = rho >> 4, i = rho & 15; return 8 * (i >> 2) + 4 * n + (i & 3); }
__device__ __forceinline__ unsigned cvt_pk_bf16(float lo, float hi) { unsigned r; asm volatile("v_cvt_pk_bf16_f32 %0, %1, %2" : "=v"(r) : "v"(lo), "v"(hi)); return r; }

template <class Epi, class Sched>
__device__ __forceinline__ void gemm_phase(LAS unsigned char* lds, const bf16_t* Abase, int ldb, int K, const Sched& S, const Epi& E) {
    const int tid = threadIdx.x, wid = __builtin_amdgcn_readfirstlane(tid >> 6), lane = tid & 63, wr = wid >> 2, wc = wid & 3, fr = lane & 15, fq = lane >> 4;
    const int nt = K / BK;
    unsigned voffB[2];
#pragma unroll
    for (int i = 0; i < 2; ++i) { int R_, C_; stage_rc(tid * 16 + i * 8192, R_, C_); const int Rb = Epi::PERM ? ((R_ & ~31) + perm32(R_ & 31)) : R_; voffB[i] = (unsigned)(Rb * ldb + C_) * 2u; }
    const size_t kstep = (size_t)(BK * 2);
    const size_t hstepB = (size_t)HALF * ldb * 2;
    const unsigned ldsw = (unsigned)wid * 1024u;
    const int aoff = lds_byte(wr * 64 + fr, fq * 8), boff = lds_byte(wc * 32 + fr, fq * 8);
#define PG8_SA(b, h) (((b) * 2 + (h)) * HTB)
#define PG8_SB(b, h) ((4 + (b) * 2 + (h)) * HTB)
#define PG8_STAGE(bufoff, gbase, voff) do { _Pragma("unroll") for (int _i = 0; _i < 2; ++_i) \
        __builtin_amdgcn_global_load_lds((const unsigned*)((const char*)(gbase) + (voff)[_i]), (LAS unsigned*)(lds + (bufoff) + ldsw + _i * 8192), 16, 0, 0); } while (0)
#define PG8_LDA(dst, b, h) do { _Pragma("unroll") for (int m = 0; m < 4; ++m) _Pragma("unroll") for (int k = 0; k < 2; ++k) dst[m][k] = *(const LAS bf16x8*)(lds + PG8_SA(b, h) + aoff + m * 2048 + k * 1024); } while (0)
#define PG8_LDB(dst, b, h) do { _Pragma("unroll") for (int n = 0; n < 2; ++n) _Pragma("unroll") for (int k = 0; k < 2; ++k) dst[n][k] = *(const LAS bf16x8*)(lds + PG8_SB(b, h) + boff + n * 2048 + k * 1024); } while (0)
#define PG8_MMA(ai, bj, At, Bt) do { __builtin_amdgcn_s_setprio(1); _Pragma("unroll") for (int m = 0; m < 4; ++m) _Pragma("unroll") for (int n = 0; n < 2; ++n) _Pragma("unroll") for (int k = 0; k < 2; ++k) \
        acc[ai][bj][m][n] = __builtin_amdgcn_mfma_f32_16x16x32_bf16(Bt[n][k], At[m][k], acc[ai][bj][m][n], 0, 0, 0); __builtin_amdgcn_s_setprio(0); } while (0)
#define PG8_WAIT_V(n) asm volatile("s_waitcnt vmcnt(" #n ")" ::: "memory")
#define PG8_WAIT_L(n) asm volatile("s_waitcnt lgkmcnt(" #n ")" ::: "memory")
#define PG8_BAR __builtin_amdgcn_s_barrier()
#define PG8_SCHED __builtin_amdgcn_sched_barrier(0)
    typename Sched::Unit cur, nxt; int ui = 0;
    if (!S.next(0, cur)) return;
    f32x4 acc[2][2][4][2];
#pragma unroll
    for (int a = 0; a < 2; ++a)
#pragma unroll
        for (int b = 0; b < 2; ++b)
#pragma unroll
            for (int m = 0; m < 4; ++m)
#pragma unroll
                for (int n = 0; n < 2; ++n) acc[a][b][m][n] = (f32x4){0.f, 0.f, 0.f, 0.f};
    bf16x8 At[4][2], B0[2][2], B1[2][2];
    unsigned cvA[2][2];
    S.a_offsets(cur, cvA);
    const char* cB = S.b_ptr(cur);
    const char* const cA = (const char*)Abase;
    PG8_STAGE(PG8_SB(0, 0), cB, voffB); PG8_STAGE(PG8_SB(0, 1), cB + hstepB, voffB); PG8_STAGE(PG8_SA(0, 0), cA, cvA[0]); PG8_STAGE(PG8_SA(0, 1), cA, cvA[1]);
    if (wr == 1) PG8_BAR;
    PG8_WAIT_V(2); PG8_BAR;
    PG8_STAGE(PG8_SB(1, 0), cB + kstep, voffB); PG8_STAGE(PG8_SA(1, 0), cA + kstep, cvA[0]); PG8_STAGE(PG8_SB(1, 1), cB + hstepB + kstep, voffB);
    PG8_WAIT_V(6); PG8_BAR;
    for (;;) {
        const bool has_next = S.next(ui + 1, nxt);
        const char* nB = has_next ? S.b_ptr(nxt) : cB;
#pragma unroll 1
        for (int t = 0; t < nt; t += 2) {
            const bool last = (t == nt - 2);
            const char* a1 = cA + (size_t)(t + 1) * kstep;
            const char* a2 = last ? cA : cA + (size_t)(t + 2) * kstep; const char* b2 = last ? nB : cB + (size_t)(t + 2) * kstep;
            const char* a3 = a2 + kstep; const char* b3 = b2 + kstep;
            PG8_LDB(B0, 0, 0); PG8_LDB(B1, 0, 1); PG8_SCHED; PG8_LDA(At, 0, 0); PG8_STAGE(PG8_SA(1, 1), a1, cvA[1]);
            if (last && has_next) S.a_offsets(nxt, cvA);
            PG8_WAIT_V(8); PG8_WAIT_L(0); PG8_BAR; PG8_MMA(0, 0, At, B0); PG8_MMA(0, 1, At, B1); PG8_BAR; PG8_SCHED;
            PG8_LDA(At, 0, 1); PG8_STAGE(PG8_SB(0, 0), b2, voffB); PG8_STAGE(PG8_SB(0, 1), b2 + hstepB, voffB); PG8_STAGE(PG8_SA(0, 0), a2, cvA[0]);
            PG8_WAIT_V(8); PG8_WAIT_L(0); PG8_BAR; PG8_MMA(1, 0, At, B0); PG8_MMA(1, 1, At, B1); PG8_BAR; PG8_SCHED;
            PG8_LDB(B0, 1, 0); PG8_LDB(B1, 1, 1); PG8_SCHED; PG8_LDA(At, 1, 0); PG8_STAGE(PG8_SA(0, 1), a2, cvA[1]);
            PG8_WAIT_V(8); PG8_WAIT_L(0); PG8_BAR; PG8_MMA(0, 0, At, B0); PG8_MMA(0, 1, At, B1); PG8_BAR; PG8_SCHED;
            PG8_LDA(At, 1, 1); PG8_STAGE(PG8_SB(1, 0), b3, voffB); PG8_STAGE(PG8_SB(1, 1), b3 + hstepB, voffB); PG8_STAGE(PG8_SA(1, 0), a3, cvA[0]);
            PG8_WAIT_V(8); PG8_WAIT_L(0); PG8_BAR; PG8_MMA(1, 0, At, B0); PG8_MMA(1, 1, At, B1); PG8_BAR; PG8_SCHED;
        }
        if (wr == 0) PG8_BAR;
        E(acc, cur, wr, wc, fr, fq);
        if (!has_next) break;
#pragma unroll
        for (int a = 0; a < 2; ++a)
#pragma unroll
            for (int b = 0; b < 2; ++b)
#pragma unroll
                for (int m = 0; m < 4; ++m)
#pragma unroll
                    for (int n = 0; n < 2; ++n) acc[a][b][m][n] = (f32x4){0.f, 0.f, 0.f, 0.f};
        cur = nxt; cB = nB; ++ui;
        if (wr == 1) PG8_BAR;
    }
    PG8_WAIT_V(0);
    PG8_BAR;
#undef PG8_SA
#undef PG8_SB
#undef PG8_STAGE
#undef PG8_LDA
#undef PG8_LDB
#undef PG8_MMA
#undef PG8_WAIT_V
#undef PG8_WAIT_L
#undef PG8_BAR
#undef PG8_SCHED
}
}

#define XB_TMO      128
#define XB_XCNT(j)  (256  + 64 * (j))
#define XB_XSUB(j)  (1280 + 64 * (j))
#define XB_XGEN(j)  (2304 + 64 * (j))
#define XB_TOP      3328
#define XB_TOPGEN   3392
#define XCD_BAR_WORDS 3456
#define XB_SPIN_CAP (1u << 18)
constexpr int CW_BAR = 8192;
__device__ __forceinline__ unsigned xb_ld(unsigned* p)              { return __hip_atomic_load(p, __ATOMIC_RELAXED, __HIP_MEMORY_SCOPE_AGENT); }
__device__ __forceinline__ unsigned xb_add(unsigned* p, unsigned v) { return __hip_atomic_fetch_add(p, v, __ATOMIC_RELAXED, __HIP_MEMORY_SCOPE_AGENT); }
__device__ __forceinline__ unsigned xb_xcc_id() { return (unsigned)__builtin_amdgcn_s_getreg((3 << 11) | 20) & 0xFu; }
#define XB_SPIN(cond, bar) do { unsigned _sp = 0; while (cond) { __builtin_amdgcn_s_sleep(1); \
    if ((++_sp & 255u) == 0u) { if (xb_ld(&(bar)[XB_TMO])) break; if (_sp > XB_SPIN_CAP) { atomicAdd(&(bar)[XB_TMO], 1u); break; } } } } while (0)
struct XcdBarrier { unsigned* bar; unsigned x; volatile LAS unsigned* st; };
__device__ __forceinline__ XcdBarrier xcd_barrier_post(unsigned* bar, volatile LAS unsigned* st) {
    XcdBarrier b; b.bar = bar; b.x = xb_xcc_id(); b.st = st;
    if (threadIdx.x == 0) (void)xb_add(&bar[XB_XCNT(b.x)], 1u);
    return b;
}
__device__ __forceinline__ void xcd_barrier_complete(unsigned* bar, unsigned x, unsigned& nloc, unsigned& nx) {
    const unsigned G = gridDim.x * gridDim.y * gridDim.z;
    unsigned sum, cnt, mine, sp = 0u;
    for (;;) {
        sum = 0u; cnt = 0u; mine = 0u;
#pragma unroll
        for (unsigned j = 0; j < 16; ++j) { const unsigned c = xb_ld(&bar[XB_XCNT(j)]); sum += c; cnt += (c > 0u) ? 1u : 0u; mine = (j == x) ? c : mine; }
        if (sum == G) break;
        __builtin_amdgcn_s_sleep(1);
        if ((++sp & 255u) == 0u) { if (xb_ld(&bar[XB_TMO])) break; if (sp > XB_SPIN_CAP) { atomicAdd(&bar[XB_TMO], 1u); break; } }
    }
    nloc = mine > 0u ? mine : 1u; nx = cnt > 0u ? cnt : 1u;
}
__device__ __forceinline__ void xcd_barrier(const XcdBarrier& b) {
    asm volatile("s_waitcnt vmcnt(0)" ::: "memory");
    __syncthreads();
    if (threadIdx.x == 0) {
        unsigned* bar = b.bar;
        __builtin_amdgcn_s_waitcnt(0);
        unsigned nloc = b.st[0], nx = b.st[1];
        if (nloc == 0u) { xcd_barrier_complete(bar, b.x, nloc, nx); b.st[0] = nloc; b.st[1] = nx; }
        const unsigned old = xb_add(&bar[XB_XSUB(b.x)], 1u);
        const unsigned gen = old / nloc;
        if (old + 1u == (gen + 1u) * nloc) {
            __builtin_amdgcn_fence(__ATOMIC_RELEASE, "agent");
            asm volatile("s_waitcnt vmcnt(0)" ::: "memory");
            const unsigned og = xb_add(&bar[XB_TOP], 1u);
            const unsigned tg = og / nx;
            if (og + 1u == (tg + 1u) * nx) xb_add(&bar[XB_TOPGEN], 1u);
            else XB_SPIN(xb_ld(&bar[XB_TOPGEN]) == tg, bar);
            __builtin_amdgcn_fence(__ATOMIC_ACQUIRE, "agent");
            xb_add(&bar[XB_XGEN(b.x)], 1u);
            asm volatile("s_waitcnt vmcnt(0)" ::: "memory");
        } else {
            XB_SPIN(xb_ld(&bar[XB_XGEN(b.x)]) == gen, bar);
            __builtin_amdgcn_fence(__ATOMIC_ACQUIRE, "agent");
            asm volatile("s_waitcnt vmcnt(0)" ::: "memory");
        }
    }
    __syncthreads();
}

__device__ __forceinline__ void p0_transpose_item(const float* W, int ldn, int k0, int n0, bf16_t* WT, int ldt, int drow0, LAS float* scr, int lane) {
#pragma unroll 8
    for (int i = 0; i < 32; ++i) { const int kk = 2 * i + (lane >> 5); scr[kk * 33 + (lane & 31)] = W[(size_t)(k0 + kk) * ldn + n0 + (lane & 31)]; }
    asm volatile("s_waitcnt lgkmcnt(0)" ::: "memory");
    const int c = lane & 7;
#pragma unroll
    for (int j = 0; j < 4; ++j) { const int n = (lane >> 3) + 8 * j; const LAS float* s = scr + (8 * c) * 33 + n;
        u32x4 o; o.x = pk2(s[0 * 33], s[1 * 33]); o.y = pk2(s[2 * 33], s[3 * 33]); o.z = pk2(s[4 * 33], s[5 * 33]); o.w = pk2(s[6 * 33], s[7 * 33]);
        *(u32x4*)(WT + (size_t)(drow0 + n) * ldt + k0 + 8 * c) = o; }
    asm volatile("s_waitcnt lgkmcnt(0)" ::: "memory");
}

__device__ __forceinline__ void stage_rows(int (&sR)[2], int (&sC)[2]) {
    int tid = threadIdx.x; asm volatile("" : "+v"(tid));
#pragma unroll
    for (int i = 0; i < 2; ++i) pg8::stage_rc(tid * 16 + i * 8192, sR[i], sC[i]);
}
struct ProjOrder {
    struct Unit { int pm, pn; };
    int G, c; const bf16_t* WIN;
    __device__ __forceinline__ bool next(int i, Unit& u) const {
        const int L = i * G + c;
        if (L < 768) { const int xcd = L & 7, off = L >> 3; u.pm = 8 * xcd + (off & 7); u.pn = off >> 3; return true; }
        if (L < 824) { const int q = L - 768; u.pm = 64 + q / 7; u.pn = 5 + q % 7; return true; }
        return false;
    }
    __device__ __forceinline__ void a_offsets(const Unit& u, unsigned (&v)[2][2]) const {
        int sR[2], sC[2]; stage_rows(sR, sC);
#pragma unroll
        for (int h = 0; h < 2; ++h)
#pragma unroll
            for (int i = 0; i < 2; ++i) v[h][i] = (unsigned)((u.pm * 256 + h * 128 + sR[i]) * DM + sC[i]) * 2u;
    }
    __device__ __forceinline__ const char* b_ptr(const Unit& u) const { return (const char*)WIN + (size_t)u.pn * 256 * DM * 2; }
};
struct EpiProj {
    static constexpr bool PERM = false;
    bf16_t* PROJ; const float* tab;
    __device__ __forceinline__ void operator()(const f32x4 (&acc)[2][2][4][2], const ProjOrder::Unit& u, int wr, int wc, int fr, int fq) const {
        const int pn = u.pn; const bool ctx = u.pm >= 64;
        const bool rope = !ctx && (pn <= 2 || pn == 5 || pn == 8 || pn == 9);
        const float scale = (pn == 1 || pn == 2) ? 0.125f * LOG2E : (pn == 5 ? 0.125f : 1.f);
#pragma unroll
        for (int ai = 0; ai < 2; ++ai)
#pragma unroll
            for (int m = 0; m < 4; ++m) {
                const int row = u.pm * 256 + ai * 128 + wr * 64 + m * 16 + fr;
                f32x4 cs = {1.f, 1.f, 1.f, 1.f}, sn = {0.f, 0.f, 0.f, 0.f};
                if (rope) { const int t = row & (SEQ - 1); const int pos = (wc & 1) ? (t & 63) : (t >> 6);
                    const f32x4 a = *(const f32x4*)(tab + (pos * 16 + 4 * fq) * 2), b = *(const f32x4*)(tab + (pos * 16 + 4 * fq) * 2 + 4);
                    cs = (f32x4){a.x, a.z, b.x, b.z}; sn = (f32x4){a.y, a.w, b.y, b.w}; }
                bf16_t* rowp = PROJ + (size_t)row * INW + pn * 256 + wc * 32 + 4 * fq;
#pragma unroll
                for (int bj = 0; bj < 2; ++bj) {
                    const f32x4 x1 = acc[ai][bj][m][0], x2 = acc[ai][bj][m][1];
                    const f32x4 o1 = (x1 * cs - x2 * sn) * scale, o2 = (x1 * sn + x2 * cs) * scale;
                    u32x2 w1, w2; w1.x = pg8::cvt_pk_bf16(o1.x, o1.y); w1.y = pg8::cvt_pk_bf16(o1.z, o1.w); w2.x = pg8::cvt_pk_bf16(o2.x, o2.y); w2.y = pg8::cvt_pk_bf16(o2.z, o2.w);
                    *(u32x2*)(rowp + bj * 128) = w1; *(u32x2*)(rowp + bj * 128 + 16) = w2;
                }
            }
    }
};


struct OutOrder {
    struct Unit { int pm, pn; };
    int G, c; const bf16_t* W;
    __device__ __forceinline__ bool next(int i, Unit& u) const { const int L = i * G + c; if (L >= 256) return false; const int xcd = L & 7, off = L >> 3; u.pm = 8 * xcd + (off & 7); u.pn = off >> 3; return true; }
    __device__ __forceinline__ void a_offsets(const Unit& u, unsigned (&v)[2][2]) const {
        int sR[2], sC[2]; stage_rows(sR, sC);
#pragma unroll
        for (int h = 0; h < 2; ++h)
#pragma unroll
            for (int i = 0; i < 2; ++i) v[h][i] = (unsigned)((u.pm * 256 + h * 128 + sR[i]) * DM + sC[i]) * 2u;
    }
    __device__ __forceinline__ const char* b_ptr(const Unit& u) const { return (const char*)W + (size_t)u.pn * 256 * DM * 2; }
};
struct EpiOut {
    static constexpr bool PERM = false;
    const float* x; float* out; const float* g1;
    __device__ __forceinline__ void operator()(const f32x4 (&acc)[2][2][4][2], const OutOrder::Unit& u, int wr, int wc, int fr, int fq) const {
        const int col0 = u.pn * 256 + wc * 32 + 4 * fq;
#pragma unroll
        for (int ai = 0; ai < 2; ++ai)
#pragma unroll
            for (int m = 0; m < 4; ++m) {
                const int row = u.pm * 256 + ai * 128 + wr * 64 + m * 16 + fr; const int b = row >> 11;
                const size_t off = (size_t)row * DM + col0; const float* gp = g1 + (size_t)b * 6144 + col0;
#pragma unroll
                for (int bj = 0; bj < 2; ++bj)
#pragma unroll
                    for (int n = 0; n < 2; ++n) { const int o = bj * 128 + n * 16; *(f32x4*)(out + off + o) = *(const f32x4*)(x + off + o) + *(const f32x4*)(gp + o) * acc[ai][bj][m][n]; }
            }
    }
};
struct PoolOrder {
    struct Unit { int pm, pn; };
    int G, c; const bf16_t* W;
    __device__ __forceinline__ bool next(int i, Unit& u) const { const int L = i * G + c; if (L >= 256) return false; const int xcd = L & 7, off = L >> 3; u.pm = 8 * xcd + (off & 7); u.pn = off >> 3; return true; }
    __device__ __forceinline__ void a_offsets(const Unit& u, unsigned (&v)[2][2]) const {
        int sR[2], sC[2]; stage_rows(sR, sC);
#pragma unroll
        for (int h = 0; h < 2; ++h)
#pragma unroll
            for (int i = 0; i < 2; ++i) v[h][i] = (unsigned)((u.pm * 256 + h * 128 + sR[i]) * DM + u.pn * 256 + sC[i]) * 2u;
    }
    __device__ __forceinline__ const char* b_ptr(const Unit& u) const { return (const char*)W + (size_t)u.pn * 65536 * 2; }
};
template <class U> struct EpiStoreBf16 {
    static constexpr bool PERM = false;
    bf16_t* O; int ldo;
    __device__ __forceinline__ void operator()(const f32x4 (&acc)[2][2][4][2], const U& u, int wr, int wc, int fr, int fq) const {
#pragma unroll
        for (int ai = 0; ai < 2; ++ai)
#pragma unroll
            for (int m = 0; m < 4; ++m) {
                bf16_t* rowp = O + (size_t)(u.orow0() + ai * 128 + wr * 64 + m * 16 + fr) * ldo + u.ocol0() + wc * 32 + 4 * fq;
#pragma unroll
                for (int bj = 0; bj < 2; ++bj)
#pragma unroll
                    for (int n = 0; n < 2; ++n) { const f32x4 v = acc[ai][bj][m][n]; u32x2 w; w.x = pg8::cvt_pk_bf16(v.x, v.y); w.y = pg8::cvt_pk_bf16(v.z, v.w); *(u32x2*)(rowp + bj * 128 + n * 16) = w; }
            }
    }
};
struct PoolUnitView { int pm, pn; __device__ __forceinline__ int orow0() const { return pm * 256; } __device__ __forceinline__ int ocol0() const { return pn * 256; } };
struct EpiPool { static constexpr bool PERM = false; bf16_t* O;
    __device__ __forceinline__ void operator()(const f32x4 (&acc)[2][2][4][2], const PoolOrder::Unit& u, int wr, int wc, int fr, int fq) const { EpiStoreBf16<PoolUnitView> e{O, DM}; e(acc, PoolUnitView{u.pm, u.pn}, wr, wc, fr, fq); } };

struct MoeUnit { int e, t0, rowbase, pn, cnt; __device__ __forceinline__ int orow0() const { return rowbase; } __device__ __forceinline__ int ocol0() const { return pn * 256; } };
__device__ __forceinline__ void moe_setup(volatile LAS unsigned* MISC, const unsigned* cnt) {
    __syncthreads();
    if (threadIdx.x == 0) { unsigned base = 0; for (int e = 0; e < NE; ++e) { const unsigned c = cnt[e * 64]; MISC[16 + e] = base; MISC[33 + e] = c; base += (c + 255u) >> 8; } MISC[32] = base; }
    __syncthreads();
}
template <int GATHER> struct MoeOrderT {
    typedef MoeUnit Unit;
    int G, vcu; volatile LAS unsigned* MISC; const int* tok_of; const bf16_t* W;
    __device__ __forceinline__ bool next(int i, Unit& u) const {
        const int L = i * G + vcu; const int NT = __builtin_amdgcn_readfirstlane((int)MISC[32]); if (L >= 4 * NT) return false;
        const int T = L >> 2; u.pn = L & 3; int e = 0;
#pragma unroll
        for (int k = 1; k < NE; ++k) e = (__builtin_amdgcn_readfirstlane((int)MISC[16 + k]) <= T) ? k : e;
        e = __builtin_amdgcn_readfirstlane(e);
        u.e = e; u.t0 = __builtin_amdgcn_readfirstlane((T - (int)MISC[16 + e]) * 256); u.rowbase = T * 256; u.cnt = __builtin_amdgcn_readfirstlane((int)MISC[33 + e]); return true;
    }
    __device__ __forceinline__ void a_offsets(const Unit& u, unsigned (&v)[2][2]) const {
        int sR[2], sC[2]; stage_rows(sR, sC);
#pragma unroll
        for (int h = 0; h < 2; ++h)
#pragma unroll
            for (int i = 0; i < 2; ++i) {
                if (GATHER) { int r = u.t0 + h * 128 + sR[i]; if (r >= u.cnt) r = 0; const int tok = tok_of[u.e * ECAP + r]; v[h][i] = (unsigned)(tok * DM + sC[i]) * 2u; }
                else v[h][i] = (unsigned)((u.rowbase + h * 128 + sR[i]) * DE + sC[i]) * 2u;
            }
    }
    __device__ __forceinline__ const char* b_ptr(const Unit& u) const { return (const char*)W + ((size_t)u.e * 1024 + u.pn * 256) * (GATHER ? DM : DE) * 2; }
};
struct EpiGateUp {
    static constexpr bool PERM = false;
    bf16_t* HID; const float* w_of;
    __device__ __forceinline__ void operator()(const f32x4 (&acc)[2][2][4][2], const MoeUnit& u, int wr, int wc, int fr, int fq) const {
#pragma unroll
        for (int ai = 0; ai < 2; ++ai)
#pragma unroll
            for (int m = 0; m < 4; ++m) {
                const int rl = ai * 128 + wr * 64 + m * 16 + fr; const int pos = u.t0 + rl;
                const float w = pos < u.cnt ? w_of[u.e * ECAP + pos] : 0.f;
                bf16_t* rowp = HID + (size_t)(u.rowbase + rl) * DE + u.pn * 128 + wc * 32 + 4 * fq;
#pragma unroll
                for (int n = 0; n < 2; ++n) { const f32x4 g = acc[ai][0][m][n], up = acc[ai][1][m][n]; f32x4 h;
#pragma unroll
                    for (int k = 0; k < 4; ++k) h[k] = g[k] / (1.f + __expf(-g[k])) * up[k] * w;
                    u32x2 o; o.x = pg8::cvt_pk_bf16(h.x, h.y); o.y = pg8::cvt_pk_bf16(h.z, h.w); *(u32x2*)(rowp + n * 16) = o; }
            }
    }
};
struct EpiDown { static constexpr bool PERM = false; bf16_t* Y;
    __device__ __forceinline__ void operator()(const f32x4 (&acc)[2][2][4][2], const MoeUnit& u, int wr, int wc, int fr, int fq) const { EpiStoreBf16<MoeUnit> e{Y, DM}; e(acc, u, wr, wc, fr, fq); } };

template <int LAYER> __device__ __forceinline__ void moe_gateup_phase(LAS unsigned char* lds, volatile LAS unsigned* MISC, unsigned char* ws, int G, int vcu) {
    const int* tok_of = (const int*)(ws + WS_ROUTE) + 6 * NTOK; const float* w_of = (const float*)(tok_of + 16 * ECAP);
    moe_setup(MISC, (const unsigned*)(ws + WS_CTL) + CW_CNT + LAYER * 16 * 64);
    MoeOrderT<1> S{G, vcu, MISC, tok_of, (const bf16_t*)(ws + WS_WGU) + (size_t)LAYER * 16 * 1024 * 1024};
    EpiGateUp E{(bf16_t*)(ws + WS_HID), w_of};
    pg8::gemm_phase<EpiGateUp, MoeOrderT<1>>(lds, (const bf16_t*)(ws + WS_RA), DM, DM, S, E);
}
template <int LAYER> __device__ __forceinline__ void moe_down_phase(LAS unsigned char* lds, volatile LAS unsigned* MISC, unsigned char* ws, int G, int vcu) {
    moe_setup(MISC, (const unsigned*)(ws + WS_CTL) + CW_CNT + LAYER * 16 * 64);
    MoeOrderT<0> S{G, vcu, MISC, nullptr, (const bf16_t*)(ws + WS_WD) + (size_t)LAYER * 16 * 1024 * 512};
    EpiDown E{(bf16_t*)(ws + WS_Y)};
    pg8::gemm_phase<EpiDown, MoeOrderT<0>>(lds, (const bf16_t*)(ws + WS_HID), DE, DE, S, E);
}

namespace att {
typedef float f32x16 __attribute__((ext_vector_type(16)));
typedef short s16x4 __attribute__((ext_vector_type(4)));
#define ATT_KSWZ(row, colB) ((row) * 256 + ((colB) ^ (((row) & 7) << 4)))
#define ATT_SBAR() __builtin_amdgcn_sched_barrier(0)
constexpr float THR = 8.f;
__device__ __forceinline__ int crow(int r, int hi) { return (r & 3) + 8 * (r >> 2) + 4 * hi; }
__device__ __forceinline__ unsigned cvtpk(float lo, float hi) { unsigned r; asm volatile("v_cvt_pk_bf16_f32 %0, %1, %2" : "=v"(r) : "v"(lo), "v"(hi)); return r; }
__device__ __forceinline__ void partialSM(f32x16& p0, f32x16& p1, float& m_reg, float& mn, float& alpha) {
    float pmax = p0[0];
#pragma unroll
    for (int r = 1; r < 16; ++r) pmax = fmaxf(pmax, p0[r]);
#pragma unroll
    for (int r = 0; r < 16; ++r) pmax = fmaxf(pmax, p1[r]);
    { auto rr = __builtin_amdgcn_permlane32_swap(__float_as_uint(pmax), __float_as_uint(pmax), false, false); pmax = fmaxf(__uint_as_float(rr[0]), __uint_as_float(rr[1])); }
    if (__builtin_expect(__all(pmax - m_reg <= THR), 1)) { mn = m_reg; alpha = 1.f; }
    else { mn = fmaxf(m_reg, pmax); alpha = __builtin_amdgcn_exp2f(m_reg - mn); m_reg = mn; }
#pragma unroll
    for (int r = 0; r < 16; ++r) { p0[r] -= mn; p1[r] -= mn; }
#pragma unroll
    for (int r = 0; r < 16; ++r) p0[r] = __builtin_amdgcn_exp2f(p0[r]);
}
__device__ __forceinline__ void finishSM(f32x16& p0, f32x16& p1, float alpha, float& l_reg, bf16x8& pa0, bf16x8& pa1, bf16x8& pa2, bf16x8& pa3) {
#pragma unroll
    for (int r = 0; r < 16; ++r) p1[r] = __builtin_amdgcn_exp2f(p1[r]);
    float ps = 0.f;
#pragma unroll
    for (int r = 0; r < 16; ++r) ps += p0[r];
#pragma unroll
    for (int r = 0; r < 16; ++r) ps += p1[r];
    { auto rr = __builtin_amdgcn_permlane32_swap(__float_as_uint(ps), __float_as_uint(ps), false, false); ps = __uint_as_float(rr[0]) + __uint_as_float(rr[1]); }
    l_reg = l_reg * alpha + ps;
#define ATT_PK4(P, BASE, OUT) do { unsigned a0 = cvtpk(P[BASE + 0], P[BASE + 1]), a1 = cvtpk(P[BASE + 2], P[BASE + 3]);   \
    unsigned b0 = cvtpk(P[BASE + 4], P[BASE + 5]), b1 = cvtpk(P[BASE + 6], P[BASE + 7]);                              \
    auto r0 = __builtin_amdgcn_permlane32_swap(a0, b0, false, false); auto r1 = __builtin_amdgcn_permlane32_swap(a1, b1, false, false); \
    u32x4 w = {r0[0], r1[0], r0[1], r1[1]}; OUT = __builtin_bit_cast(bf16x8, w); } while (0)
    ATT_PK4(p0, 0, pa0); ATT_PK4(p0, 8, pa1); ATT_PK4(p1, 0, pa2); ATT_PK4(p1, 8, pa3);
#undef ATT_PK4
}
__device__ __forceinline__ void qkt(f32x16& p0, f32x16& p1, const LAS unsigned char* Ks, const bf16x8 (&qr)[4], int r32, int hi, int kc) {
    p0 = f32x16{}; p1 = f32x16{};
#pragma unroll
    for (int d0 = 0; d0 < 4; ++d0) { const int cb = kc + (d0 * 16 + hi * 8) * 2;
        const bf16x8 b0 = *(const LAS bf16x8*)(Ks + ATT_KSWZ(r32, cb));
        const bf16x8 b1 = *(const LAS bf16x8*)(Ks + ATT_KSWZ(32 + r32, cb));
        p0 = __builtin_amdgcn_mfma_f32_32x32x16_bf16(b0, qr[d0], p0, 0, 0, 0);
        p1 = __builtin_amdgcn_mfma_f32_32x32x16_bf16(b1, qr[d0], p1, 0, 0, 0); }
}
__device__ __forceinline__ int v_st(int k, int c) { const int kk = (k & ~0xC) | ((k & 4) << 1) | ((k & 8) >> 1); return ((kk >> 3) * 4 + (c >> 5)) * 512 + ((kk & 7) * 32 + (c & 31)) * 2; }
__device__ __forceinline__ int v_rd_base(int lane) { return ((lane & 3) << 3) | (((lane >> 2) & 3) << 6) | (((lane >> 4) & 1) << 5) | (((lane >> 5) & 1) << 8); }
constexpr int v_rd_off(int d0, int ks, int half) { return d0 * 512 + ks * 4096 + half * 2048; }
template <int OFF> __device__ __forceinline__ s16x4 tr_read(int vb) { s16x4 r; asm volatile("ds_read_b64_tr_b16 %0, %1 offset:%2" : "=&v"(r) : "v"(vb), "i"(OFF) : "memory"); return r; }
template <int D0> __device__ __forceinline__ void pv_one(f32x16& od, int vb, bf16x8 pa0, bf16x8 pa1, bf16x8 pa2, bf16x8 pa3) {
    const s16x4 l0 = tr_read<v_rd_off(D0, 0, 0)>(vb), h0 = tr_read<v_rd_off(D0, 0, 1)>(vb), l1 = tr_read<v_rd_off(D0, 1, 0)>(vb), h1 = tr_read<v_rd_off(D0, 1, 1)>(vb);
    const s16x4 l2 = tr_read<v_rd_off(D0, 2, 0)>(vb), h2 = tr_read<v_rd_off(D0, 2, 1)>(vb), l3 = tr_read<v_rd_off(D0, 3, 0)>(vb), h3 = tr_read<v_rd_off(D0, 3, 1)>(vb);
    asm volatile("s_waitcnt lgkmcnt(0)" ::: "memory"); ATT_SBAR();
#define ATT_PK(L, H) (bf16x8){L[0], L[1], L[2], L[3], H[0], H[1], H[2], H[3]}
    od = __builtin_amdgcn_mfma_f32_32x32x16_bf16(pa0, ATT_PK(l0, h0), od, 0, 0, 0);
    od = __builtin_amdgcn_mfma_f32_32x32x16_bf16(pa1, ATT_PK(l1, h1), od, 0, 0, 0);
    od = __builtin_amdgcn_mfma_f32_32x32x16_bf16(pa2, ATT_PK(l2, h2), od, 0, 0, 0);
    od = __builtin_amdgcn_mfma_f32_32x32x16_bf16(pa3, ATT_PK(l3, h3), od, 0, 0, 0);
#undef ATT_PK
}
__device__ __forceinline__ void pv_d0(f32x16 (&o)[4], int vb, bf16x8 pa0, bf16x8 pa1, bf16x8 pa2, bf16x8 pa3) {
    pv_one<0>(o[0], vb, pa0, pa1, pa2, pa3); pv_one<1>(o[1], vb, pa0, pa1, pa2, pa3); pv_one<2>(o[2], vb, pa0, pa1, pa2, pa3); pv_one<3>(o[3], vb, pa0, pa1, pa2, pa3);
}
constexpr int NT = 36, SHM_V = 16384, SHM_K = 16384, OFF_K = 2 * SHM_V, OFF_WS = 67584;
struct Stage { bf16x8 vs0, vs1, ks0, ks1; };

__device__ __forceinline__ void attn_unit(LAS unsigned char* lds, const bf16_t* __restrict__ PROJ, bf16_t* __restrict__ MIX, const float* __restrict__ subln, float lam, int b, int h, int qb) {
    const int tid = threadIdx.x, wid = __builtin_amdgcn_readfirstlane(tid >> 6), lane = tid & 63, r32 = lane & 31, hi = lane >> 5;
    const int c = wid >> 2, wq = wid & 3, kc = c * 128;
    LAS unsigned char* V_lds = lds; LAS unsigned char* K_lds = lds + OFF_K;
    LAS float* wsf = (LAS float*)(lds + OFF_WS) + wid * 64; LAS float* li_l = wsf; LAS float* al_l = wsf + 32;
    const size_t row0 = (size_t)b * SEQ + (size_t)qb * 128;
    float m_reg = -1e30f, l_reg = 0.f; f32x16 o[4] = {}; bf16x8 qr[4];
    const bf16_t* Qw = PROJ + (row0 + wq * 32 + r32) * INW + C_DQ + h * 128 + c * 64 + hi * 8;
#pragma unroll
    for (int d0 = 0; d0 < 4; ++d0) qr[d0] = *(const bf16x8*)(Qw + d0 * 16);
    const int sr = tid >> 4, sc = (tid & 15) * 8;
    const int vst0 = v_st(sr, sc), vst1 = v_st(32 + sr, sc), kst0 = ATT_KSWZ(sr, sc * 2), kst1 = ATT_KSWZ(32 + sr, sc * 2);
    const int vb0 = (int)(uintptr_t)V_lds + v_rd_base(lane);
    const bf16_t* ctxp = PROJ + (size_t)(NTOK + b * CTXL) * INW + h * 128 + sc;
    const bf16_t* latp = PROJ + (size_t)(b * SEQ) * INW + h * 128 + sc;
    Stage sg[2];
#define ATT_SLOAD(i, t) do { const bf16_t* rp_ = ((t) < 4) ? ctxp + (size_t)(t) * 64 * INW : latp + (size_t)((t) - 4) * 64 * INW; \
    sg[i].vs0 = *(const bf16x8*)(rp_ + (size_t)sr * INW + C_DV); sg[i].vs1 = *(const bf16x8*)(rp_ + (size_t)(32 + sr) * INW + C_DV); \
    sg[i].ks0 = *(const bf16x8*)(rp_ + (size_t)sr * INW + C_DK); sg[i].ks1 = *(const bf16x8*)(rp_ + (size_t)(32 + sr) * INW + C_DK); } while (0)
#define ATT_SWRITE(bf, i) do { *(LAS bf16x8*)(V_lds + (bf) * SHM_V + vst0) = sg[i].vs0; *(LAS bf16x8*)(V_lds + (bf) * SHM_V + vst1) = sg[i].vs1; \
    *(LAS bf16x8*)(K_lds + (bf) * SHM_K + kst0) = sg[i].ks0; *(LAS bf16x8*)(K_lds + (bf) * SHM_K + kst1) = sg[i].ks1; } while (0)
#define ATT_SWAIT() asm volatile("s_waitcnt vmcnt(4)" ::: "memory")
#define ATT_RESC(a) do { if (__any((a) < 1.f)) { if (hi == 0) al_l[r32] = (a); asm volatile("s_waitcnt lgkmcnt(0)" ::: "memory"); \
    _Pragma("unroll") for (int d = 0; d < 4; ++d) _Pragma("unroll") for (int r = 0; r < 16; ++r) o[d][r] *= al_l[crow(r, hi)]; } } while (0)
    f32x16 pA0, pA1, pB0, pB1; float mnA, mnB, alA, alB; bf16x8 pa0, pa1, pa2, pa3;
    ATT_SLOAD(0, 0); asm volatile("s_waitcnt vmcnt(0)" ::: "memory"); ATT_SWRITE(0, 0); __syncthreads();
    qkt(pA0, pA1, K_lds, qr, r32, hi, kc); partialSM(pA0, pA1, m_reg, mnA, alA);
    ATT_SLOAD(1, 1); ATT_SLOAD(0, 2);
    ATT_SWAIT(); ATT_SWRITE(1, 1); __syncthreads();
    for (int j = 1; j + 1 < NT; j += 2) {
        ATT_SBAR(); qkt(pB0, pB1, K_lds + SHM_K, qr, r32, hi, kc);
        finishSM(pA0, pA1, alA, l_reg, pa0, pa1, pa2, pa3); ATT_SBAR();
        ATT_SLOAD(1, j + 2); ATT_SBAR();
        pv_d0(o, vb0, pa0, pa1, pa2, pa3); partialSM(pB0, pB1, m_reg, mnB, alB);
        __syncthreads(); ATT_SWAIT(); ATT_SWRITE(0, 0);
        ATT_RESC(alB); __syncthreads();
        ATT_SBAR(); qkt(pA0, pA1, K_lds, qr, r32, hi, kc);
        finishSM(pB0, pB1, alB, l_reg, pa0, pa1, pa2, pa3); ATT_SBAR();
        if (j + 3 < NT) ATT_SLOAD(0, j + 3); ATT_SBAR();
        pv_d0(o, vb0 + SHM_V, pa0, pa1, pa2, pa3); partialSM(pA0, pA1, m_reg, mnA, alA);
        __syncthreads(); ATT_SWAIT(); ATT_SWRITE(1, 1);
        ATT_RESC(alA); __syncthreads();
    }
    ATT_SBAR(); qkt(pB0, pB1, K_lds + SHM_K, qr, r32, hi, kc);
    finishSM(pA0, pA1, alA, l_reg, pa0, pa1, pa2, pa3); ATT_SBAR();
    pv_d0(o, vb0, pa0, pa1, pa2, pa3); partialSM(pB0, pB1, m_reg, mnB, alB);
    __syncthreads(); ATT_RESC(alB);
    finishSM(pB0, pB1, alB, l_reg, pa0, pa1, pa2, pa3); ATT_SBAR();
    pv_d0(o, vb0 + SHM_V, pa0, pa1, pa2, pa3);
    if (hi == 0) li_l[r32] = l_reg; asm volatile("s_waitcnt lgkmcnt(0)" ::: "memory");
    float rli[16];
    const float fsc = c ? lam : 1.f;
#pragma unroll
    for (int r = 0; r < 16; ++r) rli[r] = __builtin_amdgcn_rcpf(li_l[crow(r, hi)]) * fsc;
    __syncthreads();
    LAS float* OB = (LAS float*)lds;
    if (c == 1) {
#pragma unroll
        for (int r = 0; r < 16; ++r)
#pragma unroll
            for (int d0 = 0; d0 < 4; ++d0) OB[(wq * 32 + crow(r, hi)) * 132 + d0 * 32 + r32] = o[d0][r] * rli[r];
    }
    __syncthreads();
    if (c == 0) {
#pragma unroll
        for (int r = 0; r < 16; ++r)
#pragma unroll
            for (int d0 = 0; d0 < 4; ++d0) { LAS float* p = OB + (wq * 32 + crow(r, hi)) * 132 + d0 * 32 + r32; *p = o[d0][r] * rli[r] - *p; }
    }
    __syncthreads();
    {
        const int row = tid >> 2, qd = tid & 3;
        f32x4 x[8]; float ss = 0.f;
#pragma unroll
        for (int k = 0; k < 8; ++k) { x[k] = *(const LAS f32x4*)(OB + row * 132 + qd * 32 + 4 * k); ss += (x[k].x * x[k].x + x[k].y * x[k].y) + (x[k].z * x[k].z + x[k].w * x[k].w); }
        ss += __shfl_xor(ss, 1); ss += __shfl_xor(ss, 2);
        const float rs = rsqrtf(ss * (1.f / 128.f) + EPS) * 0.8f;
        bf16_t* dst = MIX + (row0 + row) * DM + 512 + h * 128 + qd * 32;
#pragma unroll
        for (int k = 0; k < 4; ++k) { const f32x4 w0 = *(const f32x4*)(subln + qd * 32 + 8 * k), w1 = *(const f32x4*)(subln + qd * 32 + 8 * k + 4);
            const f32x4 a = x[2 * k] * rs * w0, bq = x[2 * k + 1] * rs * w1;
            u32x4 w; w.x = cvtpk(a.x, a.y); w.y = cvtpk(a.z, a.w); w.z = cvtpk(bq.x, bq.y); w.w = cvtpk(bq.z, bq.w);
            *(u32x4*)(dst + 8 * k) = w; }
    }
    __syncthreads();
#undef ATT_SLOAD
#undef ATT_SWRITE
#undef ATT_SWAIT
#undef ATT_RESC
}
}

namespace ret {
typedef short s16x4 __attribute__((ext_vector_type(4)));
constexpr int RS_K = 160, RS_V = 288, RS_S = 160;
constexpr int L_KF = 0, L_KB = 20480, L_V = 40960;
__device__ __forceinline__ s16x4 trr(const LAS unsigned char* p) { typedef short v4i16_t __attribute__((ext_vector_type(4))); return __builtin_bit_cast(s16x4, __builtin_amdgcn_ds_read_tr16_b64_v4i16((LAS v4i16_t*)p)); }
__device__ __forceinline__ bf16x8 cat(s16x4 a, s16x4 b) { return (bf16x8){a[0], a[1], a[2], a[3], b[0], b[1], b[2], b[3]}; }
__device__ __forceinline__ size_t xrow0(int b, int x) { return x < 2 ? (size_t)(NTOK + b * CTXL + 128 * x) : (size_t)(b * SEQ + 128 * (x - 2)); }

__device__ __forceinline__ void summary_unit(LAS unsigned char* lds, const bf16_t* __restrict__ PROJ, float* __restrict__ KVS, const float* __restrict__ ldec, int b, int h, int x) {
    const int tid = threadIdx.x, wid = __builtin_amdgcn_readfirstlane(tid >> 6), lane = tid & 63, i16 = lane & 15, g = lane >> 4;
    const float ld0 = ldec[h], ld1 = ldec[4 + h];
    const size_t R0 = xrow0(b, x);
#pragma unroll
    for (int it = 0; it < 2; ++it) { const int q = tid + 512 * it, a = q >> 3, ch = q & 7;
        const u32x4 u = *(const u32x4*)(PROJ + (R0 + a) * INW + C_RK + h * 64 + ch * 8);
        const float df = __expf(ld0 * (float)(127 - a)), db = __expf(ld1 * (float)a);
        u32x4 of, ob;
#pragma unroll
        for (int k = 0; k < 4; ++k) { const float lo = bf2f(u[k] & 0xffff), hi = bf2f(u[k] >> 16); of[k] = pg8::cvt_pk_bf16(lo * df, hi * df); ob[k] = pg8::cvt_pk_bf16(lo * db, hi * db); }
        *(LAS u32x4*)(lds + L_KF + a * RS_K + ch * 16) = of; *(LAS u32x4*)(lds + L_KB + a * RS_K + ch * 16) = ob; }
#pragma unroll
    for (int it = 0; it < 4; ++it) { const int q = tid + 512 * it, a = q >> 4, ch = q & 15;
        *(LAS u32x4*)(lds + L_V + a * RS_V + ch * 16) = *(const u32x4*)(PROJ + (R0 + a) * INW + C_RV + h * 128 + ch * 8); }
    __syncthreads();
    const int dir = wid >> 2, mb = wid & 3;
    const LAS unsigned char* Kd = lds + (dir ? L_KB : L_KF) + (4 * g + (i16 >> 2)) * RS_K + (16 * mb + 4 * (i16 & 3)) * 2;
    const LAS unsigned char* Vd = lds + L_V + (4 * g + (i16 >> 2)) * RS_V + (4 * (i16 & 3)) * 2;
    f32x4 acc[8];
#pragma unroll
    for (int nb = 0; nb < 8; ++nb) acc[nb] = (f32x4){0.f, 0.f, 0.f, 0.f};
#pragma unroll
    for (int ks = 0; ks < 4; ++ks) {
        const bf16x8 af = cat(trr(Kd + 32 * ks * RS_K), trr(Kd + (32 * ks + 16) * RS_K));
#pragma unroll
        for (int nb = 0; nb < 8; ++nb) { const bf16x8 bfv = cat(trr(Vd + 32 * ks * RS_V + 32 * nb), trr(Vd + (32 * ks + 16) * RS_V + 32 * nb));
            acc[nb] = __builtin_amdgcn_mfma_f32_16x16x32_bf16(af, bfv, acc[nb], 0, 0, 0); }
    }
    float* dst = KVS + ((((size_t)(b * 4 + h) * 18 + x) * 2 + dir) * 64 + 16 * mb + 4 * g) * 128 + i16;
#pragma unroll
    for (int nb = 0; nb < 8; ++nb)
#pragma unroll
        for (int r = 0; r < 4; ++r) dst[r * 128 + 16 * nb] = acc[nb][r];
    __syncthreads();
}

__device__ __forceinline__ void output_unit(LAS unsigned char* lds, const bf16_t* __restrict__ PROJ, const float* __restrict__ KVS, bf16_t* __restrict__ MIX, const float* __restrict__ ldec, int b, int h, int ci) {
    const int tid = threadIdx.x, wid = __builtin_amdgcn_readfirstlane(tid >> 6), lane = tid & 63, i16 = lane & 15, g = lane >> 4;
    const float ld0 = ldec[h], ld1 = ldec[4 + h];
    const size_t R0 = (size_t)b * SEQ + 128 * ci;
    {
        const int half = tid >> 8, db = (tid >> 5) & 7, eq = tid & 31;
        f32x4 sf[4], sb[4];
#pragma unroll
        for (int dd = 0; dd < 4; ++dd) { sf[dd] = (f32x4){0.f, 0.f, 0.f, 0.f}; sb[dd] = (f32x4){0.f, 0.f, 0.f, 0.f}; }
        const float* base = KVS + (size_t)(b * 4 + h) * 18 * 2 * 8192 + (size_t)(8 * db + 4 * half) * 128 + 4 * eq;
        const int nf = 2 + ci, nb = 17 - ci;
#pragma unroll 1
        for (int t0 = 0; t0 < nf; t0 += 4) {
            f32x4 tmp[4][4]; float f[4];
#pragma unroll
            for (int u = 0; u < 4; ++u) { const int x = t0 + u; const bool ok = x < nf; const int xx = ok ? x : 0;
                f[u] = ok ? __expf(ld0 * 128.f * (float)(1 + ci - x)) : 0.f; const float* src = base + (size_t)xx * 2 * 8192;
#pragma unroll
                for (int dd = 0; dd < 4; ++dd) tmp[u][dd] = *(const f32x4*)(src + dd * 128); }
#pragma unroll
            for (int u = 0; u < 4; ++u)
#pragma unroll
                for (int dd = 0; dd < 4; ++dd) sf[dd] += tmp[u][dd] * f[u];
        }
#pragma unroll 1
        for (int t0 = 0; t0 < nb; t0 += 4) {
            f32x4 tmp[4][4]; float f[4];
#pragma unroll
            for (int u = 0; u < 4; ++u) { const int t = t0 + u; const bool ok = t < nb; const int y = ok ? ci + 1 + t : 17; const int xx = y < 16 ? 2 + y : y - 16;
                f[u] = ok ? __expf(ld1 * 128.f * (float)t) : 0.f; const float* src = base + (size_t)xx * 2 * 8192 + 8192;
#pragma unroll
                for (int dd = 0; dd < 4; ++dd) tmp[u][dd] = *(const f32x4*)(src + dd * 128); }
#pragma unroll
            for (int u = 0; u < 4; ++u)
#pragma unroll
                for (int dd = 0; dd < 4; ++dd) sb[dd] += tmp[u][dd] * f[u];
        }
#pragma unroll
        for (int k = 0; k < 4; ++k) { u32x2 wf, wb; wf.x = pg8::cvt_pk_bf16(sf[0][k], sf[1][k]); wf.y = pg8::cvt_pk_bf16(sf[2][k], sf[3][k]); wb.x = pg8::cvt_pk_bf16(sb[0][k], sb[1][k]); wb.y = pg8::cvt_pk_bf16(sb[2][k], sb[3][k]);
            *(LAS u32x2*)(lds + (4 * eq + k) * RS_S + (8 * db + 4 * half) * 2) = wf; *(LAS u32x2*)(lds + 20480 + (4 * eq + k) * RS_S + (8 * db + 4 * half) * 2) = wb; }
    }
#pragma unroll
    for (int it = 0; it < 4; ++it) { const int q = tid + 512 * it, a = q >> 4, ch = q & 15;
        *(LAS u32x4*)(lds + L_V + a * RS_V + ch * 16) = *(const u32x4*)(PROJ + (R0 + a) * INW + C_RV + h * 128 + ch * 8); }
    __syncthreads();
    const int qa = 16 * wid + i16;
    bf16x8 qf[2];
#pragma unroll
    for (int ks = 0; ks < 2; ++ks) qf[ks] = *(const bf16x8*)(PROJ + (R0 + qa) * INW + C_RQ + h * 64 + 32 * ks + 8 * g);
    f32x4 o[8];
    {
        const float df = __expf(ld0 * (float)(qa + 1)), db = __expf(ld1 * (float)(128 - qa));
        const LAS unsigned char* sp = lds + i16 * RS_S + 16 * g;
#pragma unroll
        for (int eb = 0; eb < 8; ++eb) {
            f32x4 af = {0.f, 0.f, 0.f, 0.f}, ab = {0.f, 0.f, 0.f, 0.f};
#pragma unroll
            for (int ks = 0; ks < 2; ++ks) {
                const bf16x8 sf = *(const LAS bf16x8*)(sp + 16 * eb * RS_S + 64 * ks), sb = *(const LAS bf16x8*)(sp + 20480 + 16 * eb * RS_S + 64 * ks);
                af = __builtin_amdgcn_mfma_f32_16x16x32_bf16(sf, qf[ks], af, 0, 0, 0); ab = __builtin_amdgcn_mfma_f32_16x16x32_bf16(sb, qf[ks], ab, 0, 0, 0); }
            o[eb] = af * df + ab * db;
        }
    }
    f32x4 sacc[8];
#pragma unroll
    for (int kb = 0; kb < 8; ++kb) { sacc[kb] = (f32x4){0.f, 0.f, 0.f, 0.f};
#pragma unroll
        for (int ks = 0; ks < 2; ++ks) { const bf16x8 kf = *(const bf16x8*)(PROJ + (R0 + 16 * kb + i16) * INW + C_RK + h * 64 + 32 * ks + 8 * g);
            sacc[kb] = __builtin_amdgcn_mfma_f32_16x16x32_bf16(kf, qf[ks], sacc[kb], 0, 0, 0); } }
#pragma unroll
    for (int kb = 0; kb < 8; ++kb)
#pragma unroll
        for (int r = 0; r < 4; ++r) { const int d = qa - (16 * kb + 4 * g + r); const float wgt = d > 0 ? __expf(ld0 * (float)d) : (d < 0 ? __expf(ld1 * (float)(-d)) : 2.f); sacc[kb][r] *= wgt; }
    const LAS unsigned char* Vd = lds + L_V + (4 * g + (i16 >> 2)) * RS_V + (4 * (i16 & 3)) * 2;
#pragma unroll
    for (int s4 = 0; s4 < 4; ++s4) {
        u32x4 pw; pw.x = pg8::cvt_pk_bf16(sacc[2 * s4][0], sacc[2 * s4][1]); pw.y = pg8::cvt_pk_bf16(sacc[2 * s4][2], sacc[2 * s4][3]);
        pw.z = pg8::cvt_pk_bf16(sacc[2 * s4 + 1][0], sacc[2 * s4 + 1][1]); pw.w = pg8::cvt_pk_bf16(sacc[2 * s4 + 1][2], sacc[2 * s4 + 1][3]);
        const bf16x8 pf = __builtin_bit_cast(bf16x8, pw);
#pragma unroll
        for (int eb = 0; eb < 8; ++eb) { const bf16x8 vf = cat(trr(Vd + 32 * s4 * RS_V + 32 * eb), trr(Vd + (32 * s4 + 16) * RS_V + 32 * eb));
            o[eb] = __builtin_amdgcn_mfma_f32_16x16x32_bf16(vf, pf, o[eb], 0, 0, 0); }
    }
    float ss = 0.f;
#pragma unroll
    for (int eb = 0; eb < 8; ++eb) ss += (o[eb][0] * o[eb][0] + o[eb][1] * o[eb][1]) + (o[eb][2] * o[eb][2] + o[eb][3] * o[eb][3]);
    ss += __shfl_xor(ss, 16); ss += __shfl_xor(ss, 32);
    const float rs = rsqrtf(ss * (1.f / 128.f) + EPS);
    const bf16_t* gp = PROJ + (R0 + qa) * INW + C_RG + h * 128 + 4 * g;
    bf16_t* mp = MIX + (R0 + qa) * DM + h * 128 + 4 * g;
#pragma unroll
    for (int eb = 0; eb < 8; ++eb) { const u32x2 gu = *(const u32x2*)(gp + 16 * eb);
        const float g0 = bf2f(gu.x & 0xffff), g1 = bf2f(gu.x >> 16), g2 = bf2f(gu.y & 0xffff), g3 = bf2f(gu.y >> 16);
        u32x2 w; w.x = pg8::cvt_pk_bf16(o[eb][0] * rs * silu_f(g0), o[eb][1] * rs * silu_f(g1)); w.y = pg8::cvt_pk_bf16(o[eb][2] * rs * silu_f(g2), o[eb][3] * rs * silu_f(g3));
        *(u32x2*)(mp + 16 * eb) = w; }
    __syncthreads();
}
}

template <int R> __device__ __forceinline__ void rows_load(const float* p, int lane, f32x4 (&v)[R][4]) {
#pragma unroll
    for (int r = 0; r < R; ++r)
#pragma unroll
        for (int j = 0; j < 4; ++j) v[r][j] = *(const f32x4*)(p + (size_t)r * DM + 256 * j + 4 * lane);
}
template <int R> __device__ __forceinline__ void rows_store(float* p, int lane, const f32x4 (&v)[R][4]) {
#pragma unroll
    for (int r = 0; r < R; ++r)
#pragma unroll
        for (int j = 0; j < 4; ++j) *(f32x4*)(p + (size_t)r * DM + 256 * j + 4 * lane) = v[r][j];
}
template <int R> __device__ __forceinline__ void rows_rstd(const f32x4 (&v)[R][4], float (&rs)[R]) {
#pragma unroll
    for (int r = 0; r < R; ++r) { float q = 0.f;
#pragma unroll
        for (int j = 0; j < 4; ++j) q += (v[r][j].x * v[r][j].x + v[r][j].y * v[r][j].y) + (v[r][j].z * v[r][j].z + v[r][j].w * v[r][j].w);
        rs[r] = q; }
#pragma unroll
    for (int o = 1; o < 64; o <<= 1)
#pragma unroll
        for (int r = 0; r < R; ++r) rs[r] += __shfl_xor(rs[r], o);
#pragma unroll
    for (int r = 0; r < R; ++r) rs[r] = rsqrtf(rs[r] * (1.f / 1024.f) + EPS);
}
__device__ __forceinline__ void mod_cache(const float* nw, const float* sh, const float* sc, int lane, f32x4 (&ma)[4], f32x4 (&mb)[4]) {
#pragma unroll
    for (int j = 0; j < 4; ++j) { const int c = 256 * j + 4 * lane; ma[j] = *(const f32x4*)(nw + c) * (*(const f32x4*)(sc + c) + 1.f); mb[j] = *(const f32x4*)(sh + c); }
}
template <int R> __device__ __forceinline__ void rows_normmod_store(f32x4 (&v)[R][4], const float (&rs)[R], const f32x4 (&ma)[4], const f32x4 (&mb)[4], bf16_t* dst, int lane) {
#pragma unroll
    for (int r = 0; r < R; ++r)
#pragma unroll
        for (int j = 0; j < 4; ++j) { v[r][j] = v[r][j] * rs[r] * ma[j] + mb[j];
            u32x2 w; w.x = pg8::cvt_pk_bf16(v[r][j].x, v[r][j].y); w.y = pg8::cvt_pk_bf16(v[r][j].z, v[r][j].w); *(u32x2*)(dst + (size_t)r * DM + 256 * j + 4 * lane) = w; }
}
__device__ __forceinline__ void router_table_load(LAS unsigned char* lds, const float* router_w) {
    for (int g = threadIdx.x; g < 4096; g += 512) { const int k = g >> 2, q = g & 3, j = k >> 8, l = (k & 255) >> 2, i = k & 3, c = 4 * i + q;
        *(LAS f32x4*)(lds + j * 16384 + l * 256 + ((c ^ (l & 15)) << 4)) = *(const f32x4*)(router_w + (size_t)g * 4); }
    __syncthreads();
}
template <int R> __device__ __forceinline__ void rows_logits(f32x4 (&v)[R][4], const LAS unsigned char* tab, int lane, float (&out)[R]) {
    f32x4 lg[R][4];
#pragma unroll
    for (int r = 0; r < R; ++r)
#pragma unroll
        for (int q = 0; q < 4; ++q) lg[r][q] = (f32x4){0.f, 0.f, 0.f, 0.f};
    const LAS unsigned char* rw = tab + lane * 256; const int sw = lane & 15;
#pragma unroll 1
    for (int j = 0; j < 4; ++j) {
        f32x4 w[4][4];
#pragma unroll
        for (int i = 0; i < 4; ++i)
#pragma unroll
            for (int q = 0; q < 4; ++q) w[i][q] = *(const LAS f32x4*)(rw + (((4 * i + q) ^ sw) << 4));
#pragma unroll
        for (int i = 0; i < 4; ++i)
#pragma unroll
            for (int r = 0; r < R; ++r) { const float hv = v[r][0][i];
#pragma unroll
                for (int q = 0; q < 4; ++q) lg[r][q] += w[i][q] * hv; }
#pragma unroll
        for (int r = 0; r < R; ++r) { v[r][0] = v[r][1]; v[r][1] = v[r][2]; v[r][2] = v[r][3]; }
        rw += 16384;
    }
#pragma unroll
    for (int r = 0; r < R; ++r) {
        f32x4 a8[2]; f32x4 a4; float a2[2], a1;
        { const bool up = lane & 32;
#pragma unroll
          for (int i = 0; i < 2; ++i) { const f32x4 keep = up ? lg[r][i + 2] : lg[r][i], send = up ? lg[r][i] : lg[r][i + 2];
              f32x4 rc; rc.x = __shfl_xor(send.x, 32); rc.y = __shfl_xor(send.y, 32); rc.z = __shfl_xor(send.z, 32); rc.w = __shfl_xor(send.w, 32); a8[i] = keep + rc; } }
        { const bool up = lane & 16; const f32x4 keep = up ? a8[1] : a8[0], send = up ? a8[0] : a8[1];
          f32x4 rc; rc.x = __shfl_xor(send.x, 16); rc.y = __shfl_xor(send.y, 16); rc.z = __shfl_xor(send.z, 16); rc.w = __shfl_xor(send.w, 16); a4 = keep + rc; }
        { const bool up = lane & 8; const float k0 = up ? a4.z : a4.x, k1 = up ? a4.w : a4.y, s0 = up ? a4.x : a4.z, s1 = up ? a4.y : a4.w;
          a2[0] = k0 + __shfl_xor(s0, 8); a2[1] = k1 + __shfl_xor(s1, 8); }
        { const bool up = lane & 4; const float keep = up ? a2[1] : a2[0], send = up ? a2[0] : a2[1]; a1 = keep + __shfl_xor(send, 4); }
        a1 += __shfl_xor(a1, 2); a1 += __shfl_xor(a1, 1);
        out[r] = a1;
    }
}
__device__ __forceinline__ void route_select(const float (&lg)[16], const float* router_b, int& o1, int& o2, float& w1, float& w2) {
    float sg[16], bz[16];
#pragma unroll
    for (int e = 0; e < 16; ++e) { sg[e] = 1.f / (1.f + __expf(-lg[e])); bz[e] = sg[e] + router_b[e]; }
    int gsel = 0; float gbest = -1e30f;
#pragma unroll
    for (int gi = 0; gi < 4; ++gi) {
        float m1 = -1e30f, m2 = -1e30f;
#pragma unroll
        for (int k = 0; k < 4; ++k) { const float t = bz[gi * 4 + k]; const bool a = t > m1, b = (!a) && (t > m2); m2 = a ? m1 : (b ? t : m2); m1 = a ? t : m1; }
        const float gs = m1 + m2; const bool better = gs > gbest; gbest = better ? gs : gbest; gsel = better ? gi : gsel;
    }
    int i1 = 0, i2 = 0; float m1 = -1e30f, m2 = -1e30f, s1 = 0.f, s2 = 0.f;
#pragma unroll
    for (int gi = 0; gi < 4; ++gi)
#pragma unroll
        for (int k = 0; k < 4; ++k) { const int id = gi * 4 + k; const float t = (gi == gsel) ? bz[id] : -1e30f; const float sv = sg[id];
            const bool a = t > m1, b = (!a) && (t > m2);
            i2 = a ? i1 : (b ? id : i2); m2 = a ? m1 : (b ? t : m2); s2 = a ? s1 : (b ? sv : s2);
            i1 = a ? id : i1; m1 = a ? t : m1; s1 = a ? sv : s1; }
    const float inv = 1.f / (s1 + s2); o1 = i1; o2 = i2; w1 = s1 * inv; w2 = s2 * inv;
}
struct RoutePack { int e0, e1; float w0, w1; };
__device__ __forceinline__ void route_commit(const Ptrs& P, int layer, int row0, int lane, const RoutePack& rp) {
    unsigned* cnt = (unsigned*)(P.ws + WS_CTL) + CW_CNT + layer * 16 * 64;
    int* tok_e = (int*)(P.ws + WS_ROUTE); int* tok_pos = tok_e + 4 * NTOK; int* tok_of = tok_e + 6 * NTOK; float* w_of = (float*)(tok_of + 16 * ECAP);
    int mycnt = 0;
#pragma unroll
    for (int r = 0; r < 8; ++r) { mycnt += (__builtin_amdgcn_readlane(rp.e0, r) == lane) ? 1 : 0; mycnt += (__builtin_amdgcn_readlane(rp.e1, r) == lane) ? 1 : 0; }
    int base = 0;
    if (lane < 16 && mycnt > 0) base = (int)atomicAdd(&cnt[lane * 64], (unsigned)mycnt);
    int run = base;
#pragma unroll 1
    for (int sl = 0; sl < 16; ++sl) {
        const int r = sl >> 1, k = sl & 1;
        const int e = k ? __builtin_amdgcn_readlane(rp.e1, r) : __builtin_amdgcn_readlane(rp.e0, r);
        const int wbits = k ? __builtin_amdgcn_readlane(__float_as_int(rp.w1), r) : __builtin_amdgcn_readlane(__float_as_int(rp.w0), r);
        const int pos = __builtin_amdgcn_readlane(run, e);
        run += (lane == e) ? 1 : 0;
        if (lane == 0) { tok_e[2 * (row0 + r) + k] = e; tok_pos[2 * (row0 + r) + k] = pos; tok_of[e * ECAP + pos] = row0 + r; w_of[e * ECAP + pos] = __int_as_float(wbits); }
    }
}
__device__ __forceinline__ int rowbase_lanes(const Ptrs& P, int layer, int lane) {
    const unsigned* cnt = (const unsigned*)(P.ws + WS_CTL) + CW_CNT + layer * 16 * 64;
    int c = lane < 16 ? (int)((cnt[lane * 64] + 255u) >> 8) << 8 : 0;
    int incl = c;
#pragma unroll
    for (int o = 1; o < 16; o <<= 1) { const int t = __shfl_up(incl, o); if (lane >= o) incl += t; }
    return incl - c;
}
template <int R> __device__ __forceinline__ void rows_moe_combine(const Ptrs& P, int layer, int row0, int lane, int rbl, f32x4 (&v)[R][4]) {
    const int* tok_e = (const int*)(P.ws + WS_ROUTE); const int* tok_pos = tok_e + 4 * NTOK;
    const bf16_t* Y = (const bf16_t*)(P.ws + WS_Y);
    const float* g2 = (const float*)(P.ws + WS_MOD) + (size_t)(layer * 9 + row0 / SEQ) * 6144 + 5120;
    u32x2 ya[R][4], yb[R][4];
#pragma unroll
    for (int r = 0; r < R; ++r) {
        const int e0 = __builtin_amdgcn_readfirstlane(tok_e[2 * (row0 + r)]), e1 = __builtin_amdgcn_readfirstlane(tok_e[2 * (row0 + r) + 1]);
        const int p0 = __builtin_amdgcn_readfirstlane(tok_pos[2 * (row0 + r)]), p1 = __builtin_amdgcn_readfirstlane(tok_pos[2 * (row0 + r) + 1]);
        const bf16_t* y0 = Y + (size_t)(__builtin_amdgcn_readlane(rbl, e0) + p0) * DM; const bf16_t* y1 = Y + (size_t)(__builtin_amdgcn_readlane(rbl, e1) + p1) * DM;
#pragma unroll
        for (int j = 0; j < 4; ++j) { ya[r][j] = *(const u32x2*)(y0 + 256 * j + 4 * lane); yb[r][j] = *(const u32x2*)(y1 + 256 * j + 4 * lane); }
    }
#pragma unroll
    for (int j = 0; j < 4; ++j) { const f32x4 gg = *(const f32x4*)(g2 + 256 * j + 4 * lane);
#pragma unroll
        for (int r = 0; r < R; ++r) { const u32x2 a = ya[r][j], bb = yb[r][j];
            v[r][j].x += gg.x * (bf2f(a.x & 0xffff) + bf2f(bb.x & 0xffff)); v[r][j].y += gg.y * (bf2f(a.x >> 16) + bf2f(bb.x >> 16));
            v[r][j].z += gg.z * (bf2f(a.y & 0xffff) + bf2f(bb.y & 0xffff)); v[r][j].w += gg.w * (bf2f(a.y >> 16) + bf2f(bb.y >> 16)); } }
}
template <int LAYER> __device__ __forceinline__ void rows4_norm2_logits(const Ptrs& P, const LAS unsigned char* tab, int rr, int off, int lane, f32x4 (&v)[4][4], float (&lgl)[16]) {
    {
        const float* MOD = (const float*)(P.ws + WS_MOD) + (size_t)(LAYER * 9 + rr / SEQ) * 6144;
        f32x4 ma[4], mb[4]; mod_cache(P.norm_ffn_w + LAYER * DM, MOD + 3072, MOD + 4096, lane, ma, mb);
        float rs[4]; rows_rstd<4>(v, rs);
        rows_normmod_store<4>(v, rs, ma, mb, (bf16_t*)(P.ws + WS_RA) + (size_t)rr * DM, lane);
    }
    __builtin_amdgcn_sched_barrier(0);
#pragma unroll
    for (int hf = 0; hf < 2; ++hf) {
        float t2[2]; rows_logits<2>(*(f32x4 (*)[2][4])&v[2 * hf], tab, lane, t2);
#pragma unroll
        for (int r2 = 0; r2 < 2; ++r2) { const bool mine = lane == off + 2 * hf + r2;
#pragma unroll
            for (int e = 0; e < 16; ++e) { const float val = __shfl(t2[r2], 4 * e); lgl[e] = mine ? val : lgl[e]; } }
    }
}
template <int LAYER> __device__ __forceinline__ void rows_norm2_route(const Ptrs& P, const LAS unsigned char* tab, int gw, int lane) {
    asm volatile("" : "+v"(lane));
    const int row0 = gw * 8;
    float lgl[16];
#pragma unroll
    for (int e = 0; e < 16; ++e) lgl[e] = 0.f;
#pragma unroll 1
    for (int hb = 0; hb < 2; ++hb) { const int rr = row0 + 4 * hb; f32x4 v[4][4]; rows_load<4>(P.out + (size_t)rr * DM, lane, v); rows4_norm2_logits<LAYER>(P, tab, rr, 4 * hb, lane, v, lgl); }
    RoutePack rp; route_select(lgl, P.router_b, rp.e0, rp.e1, rp.w0, rp.w1);
    route_commit(P, LAYER, row0, lane, rp);
}
__device__ __forceinline__ void rows_combine_norm1(const Ptrs& P, int gw, int lane) {
    asm volatile("" : "+v"(lane));
    const int row0 = gw * 8, b = row0 / SEQ;
    const int rbl = rowbase_lanes(P, 0, lane);
    const float* MOD = (const float*)(P.ws + WS_MOD) + (size_t)(1 * 9 + b) * 6144;
    f32x4 ma[4], mb[4]; mod_cache(P.norm_mix_w + DM, MOD + 0, MOD + 1024, lane, ma, mb);
#pragma unroll 1
    for (int hb = 0; hb < 2; ++hb) { const int rr = row0 + 4 * hb;
        f32x4 v[4][4]; rows_load<4>(P.out + (size_t)rr * DM, lane, v);
        rows_moe_combine<4>(P, 0, rr, lane, rbl, v);
        rows_store<4>(P.out + (size_t)rr * DM, lane, v);
        float rs[4]; rows_rstd<4>(v, rs);
        rows_normmod_store<4>(v, rs, ma, mb, (bf16_t*)(P.ws + WS_RA) + (size_t)rr * DM, lane); }
}
__device__ __forceinline__ f32x4 bf4_to_f32(u32x2 a) { return (f32x4){bf2f(a.x & 0xffff), bf2f(a.x >> 16), bf2f(a.y & 0xffff), bf2f(a.y >> 16)}; }
template <int J> __device__ __forceinline__ void pool_group(const bf16_t* Z, const float* pool_scale, const float* g1, int pos0, int lane, f32x4 (&v)[4][4]) {
    constexpr int w = 2 << J, left = w / 2, right = w - 1 - left;
    const int c = 256 * J + 4 * lane;
    const f32x4 gp = *(const f32x4*)(pool_scale + c) * *(const f32x4*)(g1 + c);
    u32x2 z[w + 3];
#pragma unroll
    for (int k = 0; k < w + 3; ++k) { const int t = pos0 - left + k; z[k] = (u32x2){0u, 0u};
        if (t >= 0 && t < SEQ) z[k] = *(const u32x2*)(Z + (size_t)t * DM + c); }
    f32x4 run = {0.f, 0.f, 0.f, 0.f};
#pragma unroll
    for (int k = 0; k < w; ++k) run += bf4_to_f32(z[k]);
#pragma unroll
    for (int r = 0; r < 4; ++r) {
        if (r) run += bf4_to_f32(z[r + w - 1]) - bf4_to_f32(z[r - 1]);
        const int pos = pos0 + r; int lo = pos - left; if (lo < 0) lo = 0; int hi = pos + right + 1; if (hi > SEQ) hi = SEQ;
        const float inv = 1.f / (float)(hi - lo);
        v[r][J] += gp * (run * inv - bf4_to_f32(z[r + left]));
    }
    __builtin_amdgcn_sched_barrier(0);
}
template <int OFF> __device__ __forceinline__ void rows4_pool(const Ptrs& P, int rr, int lane, f32x4 (&v)[4][4]) {
    const int b = rr / SEQ, pos0 = rr % SEQ;
    const bf16_t* Z = (const bf16_t*)(P.ws + WS_Y) + (size_t)(b * SEQ) * DM;
    const float* g1 = (const float*)(P.ws + WS_MOD) + (size_t)(1 * 9 + b) * 6144 + 2048;
    pool_group<0>(Z, P.pool_scale, g1, pos0, lane, v); pool_group<1>(Z, P.pool_scale, g1, pos0, lane, v);
    pool_group<2>(Z, P.pool_scale, g1, pos0, lane, v); pool_group<3>(Z, P.pool_scale, g1, pos0, lane, v);
}
__device__ __forceinline__ void rows_pool_norm2_route1(const Ptrs& P, const LAS unsigned char* tab, int gw, int lane) {
    asm volatile("" : "+v"(lane));
    const int row0 = gw * 8;
#pragma unroll 1
    for (int hb = 0; hb < 2; ++hb) { const int rr = row0 + 4 * hb; f32x4 v[4][4]; rows_load<4>(P.out + (size_t)rr * DM, lane, v); rows4_pool<0>(P, rr, lane, v); rows_store<4>(P.out + (size_t)rr * DM, lane, v); }
    asm volatile("s_waitcnt vmcnt(0)" ::: "memory");
    rows_norm2_route<1>(P, tab, gw, lane);
}
__device__ __forceinline__ void rows_final(const Ptrs& P, int gw, int lane) {
    asm volatile("" : "+v"(lane));
    const int row0 = gw * 8;
    const int rbl = rowbase_lanes(P, 1, lane);
    f32x4 fw[4];
#pragma unroll
    for (int j = 0; j < 4; ++j) fw[j] = *(const f32x4*)(P.final_norm_w + 256 * j + 4 * lane);
#pragma unroll 1
    for (int hb = 0; hb < 2; ++hb) { const int rr = row0 + 4 * hb;
        f32x4 v[4][4]; rows_load<4>(P.out + (size_t)rr * DM, lane, v);
        rows_moe_combine<4>(P, 1, rr, lane, rbl, v);
        float rs[4]; rows_rstd<4>(v, rs);
#pragma unroll
        for (int r = 0; r < 4; ++r)
#pragma unroll
            for (int j = 0; j < 4; ++j) v[r][j] = v[r][j] * rs[r] * fw[j];
        rows_store<4>(P.out + (size_t)rr * DM, lane, v); }
}
__device__ __forceinline__ void rows_norm_in(const Ptrs& P, int gw, int lane) {
    asm volatile("" : "+v"(lane));
    const int row0 = gw * 8, b = row0 / SEQ;
    { const float* MOD = (const float*)(P.ws + WS_MOD) + (size_t)b * 6144;
      f32x4 ma[4], mb[4]; mod_cache(P.norm_mix_w, MOD + 0, MOD + 1024, lane, ma, mb);
#pragma unroll 1
      for (int hb = 0; hb < 2; ++hb) { const int rr = row0 + 4 * hb;
          f32x4 v[4][4]; rows_load<4>(P.x + (size_t)rr * DM, lane, v);
          float rs[4]; rows_rstd<4>(v, rs);
          rows_normmod_store<4>(v, rs, ma, mb, (bf16_t*)(P.ws + WS_RA) + (size_t)rr * DM, lane); } }
    { const float* MOD = (const float*)(P.ws + WS_MOD) + (size_t)8 * 6144;
      f32x4 ma[4], mb[4]; mod_cache(P.norm_mix_w, MOD + 0, MOD + 1024, lane, ma, mb);
      f32x4 v[1][4]; rows_load<1>(P.ctx + (size_t)gw * DM, lane, v);
      float rs[1]; rows_rstd<1>(v, rs);
      rows_normmod_store<1>(v, rs, ma, mb, (bf16_t*)(P.ws + WS_RA) + (size_t)(NTOK + gw) * DM, lane); }
}

constexpr int NPHASE = 15;
struct MArgs { Ptrs P; int ph_lo, ph_hi, bar_region, pad; };
__global__ void __launch_bounds__(512, 2) mega(MArgs a) {
    extern __shared__ __attribute__((aligned(16))) unsigned char lds_raw[];
    LAS unsigned char* lds = (LAS unsigned char*)lds_raw;
    const Ptrs& P = a.P;
    const int tid = threadIdx.x, lane = tid & 63, wave = __builtin_amdgcn_readfirstlane(tid >> 6);
    const int G = gridDim.x, bx = blockIdx.x;
    const int vcu = (G % 8 == 0) ? (bx % 8) * (G / 8) + bx / 8 : bx;
    volatile LAS unsigned* MISC = (volatile LAS unsigned*)(lds + LDS_MISC);
    for (int u = tid; u < (LDS_BYTES - LDS_MISC) / 4; u += 512) ((LAS unsigned*)(lds + LDS_MISC))[u] = 0u;
    __syncthreads();
    unsigned char* ws = P.ws;
    unsigned* ctl = (unsigned*)(ws + WS_CTL);
    const int lo = a.ph_lo, hi = a.ph_hi;
    XcdBarrier bar; bar.bar = ctl + CW_BAR + a.bar_region * XCD_BAR_WORDS; bar.x = 0; bar.st = nullptr;
    if (hi - lo > 1) bar = xcd_barrier_post(ctl + CW_BAR + a.bar_region * XCD_BAR_WORDS, MISC + 8);
    const int gw = vcu * 8 + wave, NGW = G * 8;
#define IN(k) (lo <= (k) && (k) < hi)
#ifndef PROBE_TA
#define PROBE_TA -1
#endif
#ifndef PROBE_TB
#define PROBE_TB -1
#endif
    unsigned long long* TS = (unsigned long long*)(ws + WS_PAR + 65536);
#define STAMP(k) do { if ((PROBE_TA) >= 0 && bx == 0 && tid == 0) TS[k] = __builtin_amdgcn_s_memrealtime(); } while (0)
    STAMP(0);
#define SEAM(k) do { if (IN(k) && IN((k) + 1)) xcd_barrier(bar); STAMP((k) + 1); } while (0)
    if (IN(0)) {
        LAS float* scr = (LAS float*)(lds + wave * 16384);
        bf16_t* WIN = (bf16_t*)(ws + WS_WIN); bf16_t* WOUT = (bf16_t*)(ws + WS_WOUT); bf16_t* WPOOL = (bf16_t*)(ws + WS_WPOOL); bf16_t* WGU = (bf16_t*)(ws + WS_WGU); bf16_t* WD = (bf16_t*)(ws + WS_WD);
        constexpr int I_IN = 16 * 96, I_OUT = 16 * 32, I_POOL = 4 * 4 * 8, I_G = 32 * 16 * 16, I_U = I_G, I_D = 32 * 8 * 32;
        constexpr int NITEMS = I_IN + I_OUT + I_POOL + I_G + I_U + I_D;
        for (int it = gw; it < NITEMS; it += NGW) {
            int r = it;
            if (r < I_IN) { const int kb = r / 96, nb = r % 96; p0_transpose_item(P.w_in, INW, 64 * kb, 32 * nb, WIN, DM, 32 * nb, scr, lane); continue; } r -= I_IN;
            if (r < I_OUT) { const int kb = r / 32, nb = r % 32; p0_transpose_item(P.w_out, DM, 64 * kb, 32 * nb, WOUT, DM, 32 * nb, scr, lane); continue; } r -= I_OUT;
            if (r < I_POOL) { const int g = r / 32, q = r % 32, kb = q / 8, nb = q % 8; p0_transpose_item(P.pool_w + (size_t)g * 65536, 256, 64 * kb, 32 * nb, WPOOL + (size_t)g * 65536, 256, 32 * nb, scr, lane); continue; } r -= I_POOL;
            if (r < I_G + I_U) { const bool up = r >= I_G; if (up) r -= I_G; const int le = r / 256, q = r % 256, kb = q / 16, nb = q % 16, j0 = 32 * nb;
                const float* W = (up ? P.moe_w_up : P.moe_w_gate) + (size_t)le * DM * DE;
                p0_transpose_item(W, DE, 64 * kb, j0, WGU + (size_t)le * 1024 * 1024, DM, 256 * (j0 >> 7) + (j0 & 127) + (up ? 128 : 0), scr, lane); continue; } r -= I_G + I_U;
            { const int le = r / 256, q = r % 256, kb = q / 32, nb = q % 32; p0_transpose_item(P.moe_w_down + (size_t)le * DE * DM, DM, 64 * kb, 32 * nb, WD + (size_t)le * 1024 * 512, DE, 32 * nb, scr, lane); }
        }
        __syncthreads();
        for (int it = vcu; it < 192; it += G) {
            LAS float* sc = (LAS float*)lds;
            LAS float* red = (LAS float*)(lds + 40960);
            const int l = it / 96, n0 = (it % 96) * 64;
            for (int i = tid; i < 9 * 1024; i += 512) { const int r = i >> 10, k = i & 1023; const float v = r < 8 ? P.c[r * 1024 + k] : P.c_ctx[k]; sc[i] = silu_f(v); }
            __syncthreads();
            const int kq = tid >> 6, j = tid & 63;
            float acc[9];
#pragma unroll
            for (int r = 0; r < 9; ++r) acc[r] = 0.f;
            const float* W = P.ada_w + (size_t)l * 1024 * 6144 + n0 + j;
#pragma unroll 4
            for (int k = kq * 128; k < kq * 128 + 128; ++k) { const float w = W[(size_t)k * 6144];
#pragma unroll
                for (int r = 0; r < 9; ++r) acc[r] += sc[r * 1024 + k] * w; }
#pragma unroll
            for (int r = 0; r < 9; ++r) red[(kq * 9 + r) * 64 + j] = acc[r];
            __syncthreads();
            float* MOD = (float*)(ws + WS_MOD);
            for (int i = tid; i < 9 * 64; i += 512) { const int r = i >> 6, jj = i & 63; float sm = P.ada_b[l * 6144 + n0 + jj];
#pragma unroll
                for (int q = 0; q < 8; ++q) sm += red[(q * 9 + r) * 64 + jj];
                MOD[((size_t)l * 9 + r) * 6144 + n0 + jj] = sm; }
            __syncthreads();
        }
        if (vcu == G - 1) {
            float* par = (float*)(ws + WS_PAR);
            for (int i = tid; i < 64 * 16; i += 512) { const int pos = i >> 4, f = i & 15; const float inv = powf(10000.f, -(float)f / 16.f); const float ang = (float)pos * inv;
                par[2 * i] = cosf(ang); par[2 * i + 1] = sinf(ang); }
            if (tid < 64) { const float* lv = P.diff_lambda; float x = lv[tid] * lv[64 + tid], y = lv[128 + tid] * lv[192 + tid]; x = wave_sum(x); y = wave_sum(y);
                if (tid == 0) par[4096] = expf(x) - expf(y) + 0.2f; }
        }
    }
    SEAM(0);
    if (IN(1)) {
        rows_norm_in(P, gw, lane);
    }
    SEAM(1);
    if (IN(2)) {
        ProjOrder S{G, bx, (const bf16_t*)(ws + WS_WIN)};
        EpiProj E{(bf16_t*)(ws + WS_RB), (const float*)(ws + WS_PAR)};
        pg8::gemm_phase<EpiProj, ProjOrder>(lds, (const bf16_t*)(ws + WS_RA), DM, DM, S, E);
    }
    SEAM(2);
    if (IN(3)) {
        const float lam = ((const float*)(ws + WS_PAR))[4096];
        for (int U = vcu; U < 512; U += G) { const int bh = U >> 4, qb = U & 15; att::attn_unit(lds, (const bf16_t*)(ws + WS_RB), (bf16_t*)(ws + WS_RA), P.diff_subln_w, lam, bh >> 2, bh & 3, qb); }
        for (int U = vcu; U < 576; U += G) { const int bh = U / 18, x = U % 18; ret::summary_unit(lds, (const bf16_t*)(ws + WS_RB), (float*)(ws + WS_KVS), P.ret_log_decay, bh >> 2, bh & 3, x); }
    }
    SEAM(3);
    if (IN(4)) {
        for (int U = vcu; U < 512; U += G) { const int bh = U >> 4, ci = U & 15; ret::output_unit(lds, (const bf16_t*)(ws + WS_RB), (const float*)(ws + WS_KVS), (bf16_t*)(ws + WS_RA), P.ret_log_decay, bh >> 2, bh & 3, ci); }
    }
    SEAM(4);
    if (IN(5)) {
        OutOrder S{G, bx, (const bf16_t*)(ws + WS_WOUT)};
        EpiOut E{P.x, P.out, (const float*)(ws + WS_MOD) + 2048};
        pg8::gemm_phase<EpiOut, OutOrder>(lds, (const bf16_t*)(ws + WS_RA), DM, DM, S, E);
    }
    SEAM(5);
    if (IN(6)) { router_table_load(lds, P.router_w); rows_norm2_route<0>(P, lds, gw, lane); }
    SEAM(6);
    if (IN(7)) moe_gateup_phase<0>(lds, MISC, ws, G, vcu);
    SEAM(7);
    if (IN(8)) moe_down_phase<0>(lds, MISC, ws, G, vcu);
    SEAM(8);
    if (IN(9)) rows_combine_norm1(P, gw, lane);
    SEAM(9);
    if (IN(10)) {
        PoolOrder S{G, bx, (const bf16_t*)(ws + WS_WPOOL)};
        EpiPool E{(bf16_t*)(ws + WS_Y)};
        pg8::gemm_phase<EpiPool, PoolOrder>(lds, (const bf16_t*)(ws + WS_RA), 256, 256, S, E);
    }
    SEAM(10);
    if (IN(11)) { router_table_load(lds, P.router_w); rows_pool_norm2_route1(P, lds, gw, lane); }
    SEAM(11);
    if (IN(12)) moe_gateup_phase<1>(lds, MISC, ws, G, vcu);
    SEAM(12);
    if (IN(13)) moe_down_phase<1>(lds, MISC, ws, G, vcu);
    SEAM(13);
    if (IN(14)) rows_final(P, gw, lane);
    if ((PROBE_TA) >= 0) {
        STAMP(15);
        if (bx == 0 && tid == 0) {
            unsigned long long sum = 0;
            for (int k = 0; k < 15; ++k) if (((PROBE_TA) >> k) & 1) sum += TS[k + 1] - TS[k];
            const unsigned long long wait = 64ull * sum, t0 = __builtin_amdgcn_s_memrealtime();
            while (__builtin_amdgcn_s_memrealtime() - t0 < wait) __builtin_amdgcn_s_sleep(8);
        }
    }
#undef IN
#undef SEAM

}

static void launch_mega(const Ptrs& P, int lo, int hi, hipStream_t stream) { MArgs a{}; a.P = P; a.ph_lo = lo; a.ph_hi = hi; a.bar_region = 0; hipLaunchKernelGGL(mega, dim3(256), dim3(512), LDS_BYTES, stream, a); }
extern "C" void kernel_launch(void* const* d_in, const int* in_sizes, int n_in, void* d_out, int out_size, void* d_ws, size_t ws_size, hipStream_t stream) {
    if (n_in != 21 || out_size != NTOK * DM || ws_size < WS_NEED) { fprintf(stderr, "kernel_launch: bad shapes n_in %d out %d ws %zu (need %zu)\n", n_in, out_size, ws_size, (size_t)WS_NEED); return; }
    static int inited = 0;
    if (!inited) { if (hipFuncSetAttribute((const void*)mega, hipFuncAttributeMaxDynamicSharedMemorySize, LDS_BYTES) != hipSuccess) { fprintf(stderr, "hipFuncSetAttribute failed\n"); return; } inited = 1; }
    Ptrs P{};
    const float** pp = (const float**)&P;
    for (int i = 0; i < 21; ++i) pp[i] = (const float*)d_in[i];
    P.out = (float*)d_out; P.ws = (unsigned char*)d_ws;
    (void)hipMemsetAsync(P.ws + WS_CTL, 0, 1 * MiB, stream);
#ifndef MK_LAUNCHES
#define MK_LAUNCHES 1
#endif
    if (MK_LAUNCHES == 1) launch_mega(P, 0, NPHASE, stream);
    else for (int ph = 0; ph < NPHASE; ++ph) launch_mega(P, ph, ph + 1, stream);
}
```
